# Optimizing an MI355X kernel written in HIP

```python
import jax, jax.numpy as jnp
from jax import lax
import numpy as np

D_MODEL = 1024
BATCH = 8
SEQ = 4096
DEPTH = 2

N_MIXERS = 2
N_CONV_LAYERS = (DEPTH + 1) // 2
N_ATTN_LAYERS = DEPTH // 2
CONV_WIDTH = 31
ATTN_HEADS = 16
HEAD_DIM = D_MODEL // ATTN_HEADS
Q_BLOCK = 128
PEER_HEADS = 8
N_KEYS = 128
N_EXPERTS = N_KEYS * N_KEYS
PEER_TOPK = 16
KEY_DIM = 256
HALF_KEY = KEY_DIM // 2
TOKEN_CHUNK = 128
LN_EPS = 1e-5
DN_ALPHA = (2 * DEPTH) ** 0.25
DN_BETA = (8 * DEPTH) ** -0.25

kernel_name = "hybrid_conv_fox_peer_deepnorm_adaln"


def _layernorm(x, g, b):
    x32 = x.astype(jnp.float32)
    mu = jnp.mean(x32, axis=-1, keepdims=True)
    var = jnp.mean(jnp.square(x32 - mu), axis=-1, keepdims=True)
    y = (x32 - mu) * lax.rsqrt(var + LN_EPS)
    return (y * g + b).astype(x.dtype)


def _adaln(c, w, b):
    mod = jax.nn.silu(c) @ w + b
    shift, scale, gate = jnp.split(mod, 3, axis=-1)
    return shift[:, None, :], scale[:, None, :], gate[:, None, :]


def _conv_module(h, w_in, b_in, w_dw, b_dw, ln_g, ln_b, w_out, b_out):
    a = jax.nn.glu(h @ w_in + b_in, axis=-1)
    a = lax.conv_general_dilated(
        a, w_dw[:, None, :],
        window_strides=(1,), padding=[(CONV_WIDTH - 1, 0)],
        dimension_numbers=("NWC", "WIO", "NWC"),
        feature_group_count=D_MODEL) + b_dw
    a = jax.nn.silu(_layernorm(a, ln_g, ln_b))
    return a @ w_out + b_out


def _fox_attention(h, w_in, b_in, w_out, b_out):
    B_, S_, _ = h.shape
    proj = h @ w_in + b_in
    q, k, v, f = jnp.split(proj, [D_MODEL, 2 * D_MODEL, 3 * D_MODEL], axis=-1)
    q = (q * HEAD_DIM ** -0.5).reshape(B_, S_, ATTN_HEADS, HEAD_DIM).transpose(0, 2, 1, 3)
    k = k.reshape(B_, S_, ATTN_HEADS, HEAD_DIM).transpose(0, 2, 1, 3)
    v = v.reshape(B_, S_, ATTN_HEADS, HEAD_DIM).transpose(0, 2, 1, 3)
    log_f = jax.nn.log_sigmoid(f.astype(jnp.float32))
    cum = lax.cumsum(log_f, axis=1).transpose(0, 2, 1)
    n_blk = S_ // Q_BLOCK
    q_blocks = q.reshape(B_, ATTN_HEADS, n_blk, Q_BLOCK, HEAD_DIM).transpose(2, 0, 1, 3, 4)
    cum_blocks = cum.reshape(B_, ATTN_HEADS, n_blk, Q_BLOCK).transpose(2, 0, 1, 3)
    key_pos = jnp.arange(S_)

    def one_block(args):
        qb, cb, blk = args
        logits = jnp.einsum("bhqd,bhkd->bhqk", qb, k, preferred_element_type=jnp.float32)
        logits = logits + cb[..., :, None] - cum[:, :, None, :]
        q_pos = blk * Q_BLOCK + jnp.arange(Q_BLOCK)
        causal = key_pos[None, :] <= q_pos[:, None]
        p = jax.nn.softmax(jnp.where(causal, logits, -jnp.inf), axis=-1)
        return jnp.einsum("bhqk,bhkd->bhqd", p.astype(v.dtype), v)

    out = lax.map(one_block, (q_blocks, cum_blocks, jnp.arange(n_blk)))
    out = out.transpose(1, 0, 3, 2, 4).reshape(B_, S_, D_MODEL)
    return out @ w_out + b_out


def _peer(h, w_query, sub_keys_1, sub_keys_2, expert_u, expert_v):
    B_, S_, _ = h.shape
    q = (h @ w_query).reshape(B_, S_, PEER_HEADS, 2, HALF_KEY)
    s1 = jnp.einsum("bshd,kd->bshk", q[..., 0, :], sub_keys_1, preferred_element_type=jnp.float32)
    s2 = jnp.einsum("bshd,kd->bshk", q[..., 1, :], sub_keys_2, preferred_element_type=jnp.float32)
    v1, i1 = lax.top_k(s1, PEER_TOPK)
    v2, i2 = lax.top_k(s2, PEER_TOPK)
    n_cand = PEER_TOPK * PEER_TOPK
    cand_s = (v1[..., :, None] + v2[..., None, :]).reshape(B_, S_, PEER_HEADS, n_cand)
    cand_i = (i1[..., :, None] * N_KEYS + i2[..., None, :]).reshape(B_, S_, PEER_HEADS, n_cand)
    top_s, pos = lax.top_k(cand_s, PEER_TOPK)
    experts = jnp.take_along_axis(cand_i, pos, axis=-1)
    gates = jax.nn.softmax(top_s, axis=-1)
    n_tok = B_ * S_
    n_chunk = n_tok // TOKEN_CHUNK
    n_sel = PEER_HEADS * PEER_TOPK
    xs = h.reshape(n_chunk, TOKEN_CHUNK, D_MODEL)
    es = experts.reshape(n_chunk, TOKEN_CHUNK, n_sel)
    gs = gates.reshape(n_chunk, TOKEN_CHUNK, n_sel).astype(h.dtype)

    def one_chunk(args):
        xc, ec, gc = args
        u = jnp.take(expert_u, ec, axis=0)
        vv = jnp.take(expert_v, ec, axis=0)
        act = jax.nn.gelu(jnp.einsum("tkd,td->tk", u, xc), approximate=False)
        return jnp.einsum("tk,tkd->td", gc * act, vv)

    out = lax.map(one_chunk, (xs, es, gs))
    return out.reshape(B_, S_, D_MODEL)


def setup_inputs(seed: int = 0) -> dict:
    key = jax.random.key(seed)
    ks = jax.random.split(key, 32)
    f32 = jnp.float32
    D = D_MODEL
    nrm = lambda k, shape, s: jax.random.normal(k, shape, f32) * s
    attn_cols = 3 * D + ATTN_HEADS
    attn_in_b = jnp.concatenate([
        nrm(ks[14], (N_ATTN_LAYERS, 3 * D), 0.02),
        jax.random.uniform(ks[15], (N_ATTN_LAYERS, ATTN_HEADS), f32, 1.0, 4.0)], axis=-1)
    return {
        "x": nrm(ks[0], (BATCH, SEQ, D), 1.0),
        "c": nrm(ks[1], (BATCH, D), 1.0),
        "ada_mix_w": nrm(ks[2], (DEPTH, D, 3 * D), 0.5 * D ** -0.5),
        "ada_mix_b": nrm(ks[3], (DEPTH, 3 * D), 0.02),
        "ln_mix_g": 1.0 + nrm(ks[4], (DEPTH, D), 0.02),
        "ln_mix_b": nrm(ks[5], (DEPTH, D), 0.02),
        "conv_in_w": nrm(ks[6], (N_CONV_LAYERS, D, 2 * D), D ** -0.5),
        "conv_in_b": nrm(ks[7], (N_CONV_LAYERS, 2 * D), 0.02),
        "conv_dw_w": nrm(ks[8], (N_CONV_LAYERS, CONV_WIDTH, D), CONV_WIDTH ** -0.5),
        "conv_dw_b": nrm(ks[9], (N_CONV_LAYERS, D), 0.02),
        "conv_ln_g": 1.0 + nrm(ks[10], (N_CONV_LAYERS, D), 0.02),
        "conv_ln_b": nrm(ks[11], (N_CONV_LAYERS, D), 0.02),
        "conv_out_w": nrm(ks[12], (N_CONV_LAYERS, D, D), DN_BETA * D ** -0.5),
        "conv_out_b": nrm(ks[13], (N_CONV_LAYERS, D), 0.02),
        "attn_in_w": nrm(ks[16], (N_ATTN_LAYERS, D, attn_cols), D ** -0.5),
        "attn_in_b": attn_in_b,
        "attn_out_w": nrm(ks[17], (N_ATTN_LAYERS, D, D), DN_BETA * D ** -0.5),
        "attn_out_b": nrm(ks[18], (N_ATTN_LAYERS, D), 0.02),
        "ada_ffn_w": nrm(ks[19], (DEPTH, D, 3 * D), 0.5 * D ** -0.5),
        "ada_ffn_b": nrm(ks[20], (DEPTH, 3 * D), 0.02),
        "ln_ffn_g": 1.0 + nrm(ks[21], (DEPTH, D), 0.02),
        "ln_ffn_b": nrm(ks[22], (DEPTH, D), 0.02),
        "peer_query_w": nrm(ks[23], (DEPTH, D, PEER_HEADS * KEY_DIM), D ** -0.5),
        "peer_sub_keys_1": nrm(ks[24], (DEPTH, N_KEYS, HALF_KEY), HALF_KEY ** -0.5),
        "peer_sub_keys_2": nrm(ks[25], (DEPTH, N_KEYS, HALF_KEY), HALF_KEY ** -0.5),
        "peer_expert_u": nrm(ks[26], (DEPTH, N_EXPERTS, D), D ** -0.5),
        "peer_expert_v": nrm(ks[27], (DEPTH, N_EXPERTS, D), DN_BETA * PEER_HEADS ** -0.5),
    }


def reference(x, c, ada_mix_w, ada_mix_b, ln_mix_g, ln_mix_b,
              conv_in_w, conv_in_b, conv_dw_w, conv_dw_b, conv_ln_g, conv_ln_b,
              conv_out_w, conv_out_b,
              attn_in_w, attn_in_b, attn_out_w, attn_out_b,
              ada_ffn_w, ada_ffn_b, ln_ffn_g, ln_ffn_b,
              peer_query_w, peer_sub_keys_1, peer_sub_keys_2, peer_expert_u, peer_expert_v):
    for i in range(DEPTH):
        j = i // N_MIXERS
        shift, scale, gate = _adaln(c, ada_mix_w[i], ada_mix_b[i])
        h = x * (1 + scale) + shift
        if i % N_MIXERS == 0:
            y = _conv_module(h, conv_in_w[j], conv_in_b[j], conv_dw_w[j], conv_dw_b[j],
                             conv_ln_g[j], conv_ln_b[j], conv_out_w[j], conv_out_b[j])
        else:
            y = _fox_attention(h, attn_in_w[j], attn_in_b[j], attn_out_w[j], attn_out_b[j])
        x = _layernorm(DN_ALPHA * x + gate * y, ln_mix_g[i], ln_mix_b[i])
        shift, scale, gate = _adaln(c, ada_ffn_w[i], ada_ffn_b[i])
        h = x * (1 + scale) + shift
        y = _peer(h, peer_query_w[i], peer_sub_keys_1[i], peer_sub_keys_2[i],
                  peer_expert_u[i], peer_expert_v[i])
        x = _layernorm(DN_ALPHA * x + gate * y, ln_ffn_g[i], ln_ffn_b[i])
    return x
```

```cpp
#include <hip/hip_runtime.h>
#include <cstdio>
#include <cstdint>
namespace pg8 {
#define PG8_LAS __attribute__((address_space(3)))
typedef unsigned short bf16_t;
typedef short bf16x8 __attribute__((ext_vector_type(8)));
typedef float f32x4 __attribute__((ext_vector_type(4)));
typedef unsigned u32x4 __attribute__((ext_vector_type(4)));
constexpr int BM = 256, BK = 64, HALF = 128, HTB = HALF * BK * 2  , STAGE_BYTES = 8 * HTB, NXCD = 8, WGM = 8;

__host__ __device__ __forceinline__ int lds_byte(int r, int c) { const int st = (r >> 4) * 2 + (c >> 5), rr = r & 15, cc = c & 31, ob = rr * 64 + cc * 2; return st * 1024 + (ob ^ (((ob >> 9) & 1) << 5)); }
__host__ __device__ __forceinline__ void stage_rc(int b, int& R, int& C) { const int st = b / 1024, sb = b % 1024, swz = sb ^ (((sb >> 9) & 1) << 5); R = (st >> 1) * 16 + swz / 64; C = (st & 1) * 32 + (swz % 64) / 2; }
__host__ __device__ __forceinline__ int perm32(int rho) { const int n = rho >> 4, i = rho & 15; return 8 * (i >> 2) + 4 * n + (i & 3); }

struct Unit { int pm, pn; };
struct Gemm { const bf16_t* A; const bf16_t* Bt; int M, N, K; };

struct StaticOrder {
    int nM, nN, nwg, G, c;
    __host__ __device__ void init(int M, int N, int G_, int c_) { nM = M / BM; nN = N / BM; nwg = nM * nN; G = G_; c = c_; }
    __host__ __device__ bool next(int i, Unit& u) const {
        const long L = (long)i * G + c; if (L >= nwg) return false;
        int wgid = (int)L; { const int q = nwg / NXCD, r = nwg % NXCD, xcd = wgid % NXCD, off = wgid / NXCD; wgid = (xcd < r ? xcd * (q + 1) : r * (q + 1) + (xcd - r) * q) + off; }
        const int nig = WGM * nN, gid = wgid / nig, fm = gid * WGM, gsz = (nM - fm) < WGM ? (nM - fm) : WGM;
        u.pm = fm + ((wgid % nig) % gsz); u.pn = (wgid % nig) / gsz; return true;
    }
    __device__ __forceinline__ void a_ready(const Unit&) const {}
    __device__ __forceinline__ void done(const Unit&) const {}
};

__device__ __forceinline__ unsigned cvt_pk_bf16(float lo, float hi) { unsigned r; asm volatile("v_cvt_pk_bf16_f32 %0, %1, %2" : "=v"(r) : "v"(lo), "v"(hi)); return r; }
typedef float f32x2 __attribute__((ext_vector_type(2)));
__device__ __forceinline__ f32x2 gelu_pk(f32x2 v) {
    const f32x2 av = __builtin_elementwise_abs(v), d = av * 0.2316418882f + 1.0f;
    f32x2 t; t.x = __builtin_amdgcn_rcpf(d.x); t.y = __builtin_amdgcn_rcpf(d.y);
    f32x2 q = t * 0.5307027145f + (-0.7265760135f); q = q * t + 0.7107068705f; q = q * t + (-0.142248368f); q = q * t + 0.127414796f; q = q * t;
    const f32x2 s = (v * v) * (-0.72134752044f);
    f32x2 e; e.x = __builtin_amdgcn_exp2f(s.x); e.y = __builtin_amdgcn_exp2f(s.y);
    const f32x2 m = v * (q * e), r = v - m;
    f32x2 o; o.x = v.x < 0.f ? m.x : r.x; o.y = v.y < 0.f ? m.y : r.y; return o;
}

template <int ACT  > struct EpiBf16 {
    static constexpr bool PERM = true, AFTER_DRAIN = false; static_assert(ACT == 0 || ACT == 1, "EpiBf16: ACT is 0 (none) or 1 (gelu_pk)");
    bf16_t* O; int ldc; const float* bias; int split_cols; size_t split_stride; float scale0;
    __device__ __forceinline__ void operator()(const f32x4 (&acc)[2][2][4][2], const Unit& u, int wr, int wc, int fr, int fq) const {
        const int row0 = u.pm * BM + wr * 64 + fr; int colt = u.pn * BM; bf16_t* base = O;
        float sc = 1.f; if (split_cols) { const int t = colt / split_cols; base += (size_t)t * split_stride; colt -= t * split_cols; if (t == 0) sc = scale0; }
        const int col0 = colt + wc * 32 + 8 * fq, bcol0 = u.pn * BM + wc * 32 + 8 * fq;
        f32x4 bv[2][2];
#pragma unroll
        for (int bj = 0; bj < 2; ++bj)
#pragma unroll
            for (int n = 0; n < 2; ++n) bv[bj][n] = bias ? *(const f32x4*)(bias + bcol0 + bj * HALF + 4 * n) : (f32x4){0.f, 0.f, 0.f, 0.f};
#pragma unroll
        for (int ai = 0; ai < 2; ++ai)
#pragma unroll
            for (int m = 0; m < 4; ++m) { bf16_t* rowp = base + (size_t)(row0 + ai * HALF + m * 16) * ldc + col0;
#pragma unroll
                for (int bj = 0; bj < 2; ++bj) { f32x4 v0 = acc[ai][bj][m][0] + bv[bj][0], v1 = acc[ai][bj][m][1] + bv[bj][1];
                    if (ACT == 1) { f32x2 a = gelu_pk((f32x2){v0[0], v0[1]}), b = gelu_pk((f32x2){v0[2], v0[3]}), c = gelu_pk((f32x2){v1[0], v1[1]}), d = gelu_pk((f32x2){v1[2], v1[3]});
                        v0 = (f32x4){a.x, a.y, b.x, b.y}; v1 = (f32x4){c.x, c.y, d.x, d.y}; }
                    v0 = v0 * sc; v1 = v1 * sc; u32x4 w; w.x = cvt_pk_bf16(v0[0], v0[1]); w.y = cvt_pk_bf16(v0[2], v0[3]); w.z = cvt_pk_bf16(v1[0], v1[1]); w.w = cvt_pk_bf16(v1[2], v1[3]);
                    *(u32x4*)(rowp + bj * HALF) = w; } }
    }
};
template <class Epi, class Sched, bool ALIGN_EPI = false, bool SP2 = false>
__device__ __forceinline__ void gemm_phase(PG8_LAS unsigned char* lds, const Gemm g, const Sched& S, const Epi& E) {
    int tid = threadIdx.x; asm volatile("" : "+v"(tid)); const int wid = __builtin_amdgcn_readfirstlane(tid >> 6), lane = tid & 63, wr = wid >> 2, wc = wid & 3, fr = lane & 15, fq = lane >> 4;
    const int K = g.K, nt = K / BK;
    unsigned voffA[2], voffB[2];
#pragma unroll
    for (int i = 0; i < 2; ++i) { int R, C; stage_rc(tid * 16 + i * 8192, R, C); const int Rb = Epi::PERM ? ((R & ~31) + perm32(R & 31)) : R;
        voffA[i] = (unsigned)(R * K + C) * 2u; voffB[i] = (unsigned)(Rb * K + C) * 2u; }
    const size_t kstep = (size_t)(BK * 2);
    const size_t hstep = (size_t)HALF * K * 2;
    const size_t tstep = 2 * hstep;
    const unsigned ldsw = (unsigned)wid * 1024u;
    const int aoff = lds_byte(wr * 64 + fr, fq * 8), boff = lds_byte(wc * 32 + fr, fq * 8);
#define PG8_SA(b, h) (((b) * 2 + (h)) * HTB)
#define PG8_SB(b, h) ((4 + (b) * 2 + (h)) * HTB)
#define PG8_STAGE(bufoff, gbase, voff) do { _Pragma("unroll") for (int _i = 0; _i < 2; ++_i) \
        __builtin_amdgcn_global_load_lds((const unsigned*)((const char*)(gbase) + (voff)[_i]), (PG8_LAS unsigned*)(lds + (bufoff) + ldsw + _i * 8192), 16, 0, 0); } while (0)
#define PG8_LDA(dst, b, h) do { _Pragma("unroll") for (int m = 0; m < 4; ++m) _Pragma("unroll") for (int k = 0; k < 2; ++k) dst[m][k] = *(const PG8_LAS bf16x8*)(lds + PG8_SA(b, h) + aoff + m * 2048 + k * 1024); } while (0)
#define PG8_LDB(dst, b, h) do { _Pragma("unroll") for (int n = 0; n < 2; ++n) _Pragma("unroll") for (int k = 0; k < 2; ++k) dst[n][k] = *(const PG8_LAS bf16x8*)(lds + PG8_SB(b, h) + boff + n * 2048 + k * 1024); } while (0)
#define PG8_MMA(ai, bj, At, Bt) do { __builtin_amdgcn_s_setprio(1); _Pragma("unroll") for (int m = 0; m < 4; ++m) _Pragma("unroll") for (int n = 0; n < 2; ++n) _Pragma("unroll") for (int k = 0; k < 2; ++k) \
        acc[ai][bj][m][n] = __builtin_amdgcn_mfma_f32_16x16x32_bf16(Bt[n][k], At[m][k], acc[ai][bj][m][n], 0, 0, 0); __builtin_amdgcn_s_setprio(0); } while (0)
#define PG8_WAIT_V(n) asm volatile("s_waitcnt vmcnt(" #n ")" ::: "memory")
#define PG8_WAIT_L(n) asm volatile("s_waitcnt lgkmcnt(" #n ")" ::: "memory")
#define PG8_BAR __builtin_amdgcn_s_barrier()
#define PG8_SCHED __builtin_amdgcn_sched_barrier(0)
    Unit cur, nxt; int ui = 0;
    if (!S.next(0, cur)) return;
    f32x4 acc[2][2][4][2];
#pragma unroll
    for (int a = 0; a < 2; ++a)
#pragma unroll
        for (int b = 0; b < 2; ++b)
#pragma unroll
            for (int m = 0; m < 4; ++m)
#pragma unroll
                for (int n = 0; n < 2; ++n) acc[a][b][m][n] = (f32x4){0.f, 0.f, 0.f, 0.f};
    bf16x8 At[4][2], B0[2][2], B1[2][2];
    const char* cA = (const char*)g.A + (size_t)cur.pm * tstep; const char* cB = (const char*)g.Bt + (size_t)cur.pn * tstep;
    S.a_ready(cur);
    if constexpr (SP2) {
        PG8_STAGE(PG8_SB(0, 0), cB, voffB); PG8_STAGE(PG8_SB(0, 1), cB + hstep, voffB); PG8_STAGE(PG8_SA(0, 0), cA, voffA); PG8_STAGE(PG8_SA(0, 1), cA + hstep, voffA);
        if (wr == 1) PG8_BAR;
        PG8_WAIT_V(2); PG8_BAR;
        PG8_STAGE(PG8_SB(1, 0), cB + kstep, voffB); PG8_STAGE(PG8_SA(1, 0), cA + kstep, voffA); PG8_STAGE(PG8_SB(1, 1), cB + hstep + kstep, voffB);
        PG8_WAIT_V(6); PG8_BAR;
    } else {
        PG8_STAGE(PG8_SB(0, 0), cB, voffB); PG8_STAGE(PG8_SA(0, 0), cA, voffA); PG8_STAGE(PG8_SB(0, 1), cB + hstep, voffB); PG8_STAGE(PG8_SA(0, 1), cA + hstep, voffA);
        if (wr == 1) PG8_BAR;
        PG8_WAIT_V(4); PG8_BAR;
        PG8_STAGE(PG8_SB(1, 0), cB + kstep, voffB); PG8_STAGE(PG8_SA(1, 0), cA + kstep, voffA); PG8_STAGE(PG8_SB(1, 1), cB + hstep + kstep, voffB);
        PG8_WAIT_V(6); PG8_BAR;
    }
    for (;;) {
        const bool has_next = S.next(ui + 1, nxt);
        const char* nA = has_next ? (const char*)g.A + (size_t)nxt.pm * tstep : cA; const char* nB = has_next ? (const char*)g.Bt + (size_t)nxt.pn * tstep : cB;
        for (int t = 0; t < nt; t += 2) {
            const bool last = (t == nt - 2);
            const char* a1 = cA + (size_t)(t + 1) * kstep;
            const char* a2 = last ? nA : cA + (size_t)(t + 2) * kstep; const char* b2 = last ? nB : cB + (size_t)(t + 2) * kstep;
            const char* a3 = a2 + kstep; const char* b3 = b2 + kstep;
            if (last && has_next) S.a_ready(nxt);
            if constexpr (SP2) {
            PG8_LDB(B0, 0, 0); PG8_LDB(B1, 0, 1); PG8_SCHED; PG8_LDA(At, 0, 0); PG8_STAGE(PG8_SA(1, 1), a1 + hstep, voffA);
            PG8_WAIT_V(8); PG8_WAIT_L(0); PG8_BAR; PG8_MMA(0, 0, At, B0); PG8_MMA(0, 1, At, B1); PG8_BAR; PG8_SCHED;
            PG8_LDA(At, 0, 1); PG8_STAGE(PG8_SB(0, 0), b2, voffB); PG8_STAGE(PG8_SB(0, 1), b2 + hstep, voffB); PG8_STAGE(PG8_SA(0, 0), a2, voffA);
            PG8_WAIT_V(8); PG8_WAIT_L(0); PG8_BAR; PG8_MMA(1, 0, At, B0); PG8_MMA(1, 1, At, B1); PG8_BAR; PG8_SCHED;
            PG8_LDB(B0, 1, 0); PG8_LDB(B1, 1, 1); PG8_SCHED; PG8_LDA(At, 1, 0); PG8_STAGE(PG8_SA(0, 1), a2 + hstep, voffA);
            PG8_WAIT_V(8); PG8_WAIT_L(0); PG8_BAR; PG8_MMA(0, 0, At, B0); PG8_MMA(0, 1, At, B1); PG8_BAR; PG8_SCHED;
            PG8_LDA(At, 1, 1); PG8_STAGE(PG8_SB(1, 0), b3, voffB); PG8_STAGE(PG8_SB(1, 1), b3 + hstep, voffB); PG8_STAGE(PG8_SA(1, 0), a3, voffA);
            PG8_WAIT_V(8); PG8_WAIT_L(0); PG8_BAR; PG8_MMA(1, 0, At, B0); PG8_MMA(1, 1, At, B1); PG8_BAR; PG8_SCHED;
            } else {
            PG8_LDB(B0, 0, 0); PG8_SCHED; PG8_LDA(At, 0, 0); PG8_STAGE(PG8_SA(1, 1), a1 + hstep, voffA);
            PG8_WAIT_L(8); PG8_BAR; PG8_WAIT_L(0); PG8_MMA(0, 0, At, B0); PG8_BAR; PG8_SCHED;
            PG8_LDB(B1, 0, 1); PG8_STAGE(PG8_SB(0, 0), b2, voffB);
            PG8_BAR; PG8_WAIT_L(0); PG8_MMA(0, 1, At, B1); PG8_BAR;
            PG8_LDA(At, 0, 1); PG8_STAGE(PG8_SA(0, 0), a2, voffA);
            PG8_BAR; PG8_WAIT_L(0); PG8_MMA(1, 0, At, B0); PG8_BAR; PG8_SCHED;
            PG8_STAGE(PG8_SB(0, 1), b2 + hstep, voffB);
            PG8_WAIT_V(6); PG8_BAR; PG8_MMA(1, 1, At, B1); PG8_BAR;
            PG8_LDB(B0, 1, 0); PG8_SCHED; PG8_LDA(At, 1, 0); PG8_STAGE(PG8_SA(0, 1), a2 + hstep, voffA);
            PG8_WAIT_L(8); PG8_BAR; PG8_WAIT_L(0); PG8_MMA(0, 0, At, B0); PG8_BAR; PG8_SCHED;
            PG8_LDB(B1, 1, 1); PG8_STAGE(PG8_SB(1, 0), b3, voffB);
            PG8_BAR; PG8_WAIT_L(0); PG8_MMA(0, 1, At, B1); PG8_BAR;
            PG8_LDA(At, 1, 1); PG8_STAGE(PG8_SA(1, 0), a3, voffA);
            PG8_BAR; PG8_WAIT_L(0); PG8_MMA(1, 0, At, B0); PG8_BAR; PG8_SCHED;
            PG8_STAGE(PG8_SB(1, 1), b3 + hstep, voffB);
            PG8_WAIT_V(6); PG8_BAR; PG8_MMA(1, 1, At, B1); PG8_BAR;
            }
        }
        if constexpr (ALIGN_EPI) { if (wr == 0) PG8_BAR; }
        if constexpr (!Epi::AFTER_DRAIN) { E(acc, cur, wr, wc, fr, fq); S.done(cur); }
        if (!has_next) break;
#pragma unroll
        for (int a = 0; a < 2; ++a)
#pragma unroll
            for (int b = 0; b < 2; ++b)
#pragma unroll
                for (int m = 0; m < 4; ++m)
#pragma unroll
                    for (int n = 0; n < 2; ++n) acc[a][b][m][n] = (f32x4){0.f, 0.f, 0.f, 0.f};
        cur = nxt; cA = nA; cB = nB; ++ui;
        if constexpr (ALIGN_EPI) { if (wr == 1) PG8_BAR; }
    }
    PG8_WAIT_V(0);
    if constexpr (!ALIGN_EPI) { if (wr == 0) PG8_BAR; }
    PG8_BAR;
    if constexpr (Epi::AFTER_DRAIN) { E.fused(acc, cur, wr, wc, fr, fq, lds, wid, lane); S.done(cur); }
#undef PG8_SA
#undef PG8_SB
#undef PG8_STAGE
#undef PG8_LDA
#undef PG8_LDB
#undef PG8_MMA
#undef PG8_WAIT_V
#undef PG8_WAIT_L
#undef PG8_BAR
#undef PG8_SCHED
}
}

#ifndef PG8_SP2
#define PG8_SP2 true
#endif
#ifndef PG8_ALIGN
#define PG8_ALIGN true
#endif
#include <hip/hip_bf16.h>
#include <cmath>
namespace attn_body {
using bf16=__hip_bfloat16;
using bf16x8=__attribute__((ext_vector_type(8)))short;
using s16x4=__attribute__((ext_vector_type(4)))short;
using f32x16=__attribute__((ext_vector_type(16)))float;
using u32x4=__attribute__((ext_vector_type(4)))unsigned;
using f32x4_t=__attribute__((ext_vector_type(4)))float;
typedef __attribute__((address_space(3))) const float* lds_fptr;
constexpr int BATCH=8,NHEAD=16,SEQ=4096,D=64,DM=NHEAD*D;
constexpr int NW=8,QBLK=32,QB=QBLK*NW,KVBLK=64,NQB=SEQ/QB;
constexpr int ATTN_PITCH=DM, ATTN_UNIT_ROWS=QB;
__device__ __forceinline__ int crow(int r,int hi){return (r&3)+8*(r>>2)+4*hi;}
#define SBAR() __builtin_amdgcn_sched_barrier(0)
__device__ __forceinline__ void cmask(f32x16&p0,f32x16&p1,int jb,int qrel,int hi){
  const float NEG=-INFINITY; int kb=64*jb+4*hi;
  #pragma unroll
  for(int r=0;r<16;++r){int kv=kb+(r&3)+8*(r>>2); if(kv>qrel)p0[r]=NEG; if(kv+32>qrel)p1[r]=NEG;}
}

constexpr int NSLOT=3, SLOTB=8192;
constexpr int LDS_K=0, LDS_V=NSLOT*SLOTB, LDS_WS=2*NSLOT*SLOTB, LDS_OST=LDS_WS+NW*64*4, LDS_BYTES=LDS_OST+NW*4096;
constexpr float C2=0.125f*1.4426950408889634f;
__device__ __forceinline__ void glds16(const void*gsrc,unsigned lds_dst){unsigned keep;
  asm volatile("s_mov_b32 %0, m0\n\ts_mov_b32 m0, %2\n\ts_nop 0\n\tglobal_load_lds_dwordx4 %1, off\n\ts_mov_b32 m0, %0":"=&s"(keep):"v"(gsrc),"s"(lds_dst):"memory");}
__device__ __forceinline__ float max3f(float a,float b,float c){float r;asm("v_max3_f32 %0, %1, %2, %3":"=v"(r):"v"(a),"v"(b),"v"(c));return r;}
__device__ __forceinline__ float max2f(float a,float b){float r;asm("v_max_f32_e32 %0, %1, %2":"=v"(r):"v"(a),"v"(b));return r;}
__device__ __forceinline__ float fadd_s(float a,float b){float r;asm("v_add_f32_e32 %0, %1, %2":"=v"(r):"v"(a),"v"(b));return r;}
__device__ __forceinline__ float fsub_s(float a,float b){float r;asm("v_sub_f32_e32 %0, %1, %2":"=v"(r):"v"(a),"v"(b));return r;}
typedef float f32x2_t __attribute__((ext_vector_type(2))); typedef __bf16 bf16x2_t __attribute__((ext_vector_type(2)));
__device__ __forceinline__ unsigned cvtpk_s(float lo,float hi){f32x2_t v={lo,hi};bf16x2_t b=__builtin_convertvector(v,bf16x2_t);return __builtin_bit_cast(unsigned,b);}
#define WAIT_BAR(N) asm volatile("s_waitcnt vmcnt(" #N ") lgkmcnt(0)\n\ts_barrier":::"memory")

__device__ __forceinline__ void qkt(f32x16&p0,f32x16&p1,const char*Kslot,const bf16x8*qr,int r32,int hi){
  const char*kb=Kslot+hi*1024+r32*16;
  #pragma unroll
  for(int d0=0;d0<4;++d0){
    const bf16x8 b0=*reinterpret_cast<const bf16x8*>(kb+d0*2048);
    const bf16x8 b1=*reinterpret_cast<const bf16x8*>(kb+d0*2048+512);
    p0=__builtin_amdgcn_mfma_f32_32x32x16_bf16(b0,qr[d0],p0,0,0,0);p1=__builtin_amdgcn_mfma_f32_32x32x16_bf16(b1,qr[d0],p1,0,0,0);}
}
typedef __attribute__((address_space(3))) const char* lds_cptr;
typedef short v4i16_t __attribute__((ext_vector_type(4)));
__device__ __forceinline__ void kload8(bf16x8*kf,lds_cptr kp){
  kf[0]=*(const __attribute__((address_space(3))) bf16x8*)(kp);      kf[1]=*(const __attribute__((address_space(3))) bf16x8*)(kp+512);
  kf[2]=*(const __attribute__((address_space(3))) bf16x8*)(kp+2048); kf[3]=*(const __attribute__((address_space(3))) bf16x8*)(kp+2560);
  kf[4]=*(const __attribute__((address_space(3))) bf16x8*)(kp+4096); kf[5]=*(const __attribute__((address_space(3))) bf16x8*)(kp+4608);
  kf[6]=*(const __attribute__((address_space(3))) bf16x8*)(kp+6144); kf[7]=*(const __attribute__((address_space(3))) bf16x8*)(kp+6656);
}
__device__ __forceinline__ void kload2(bf16x8*kf,lds_cptr kp,int j){ kf[2*j]=*(const __attribute__((address_space(3))) bf16x8*)(kp+j*2048); kf[2*j+1]=*(const __attribute__((address_space(3))) bf16x8*)(kp+j*2048+512); }
__device__ __forceinline__ s16x4 vtr(lds_cptr p){ return __builtin_bit_cast(s16x4,__builtin_amdgcn_ds_read_tr16_b64_v4i16((__attribute__((address_space(3))) v4i16_t*)p)); }
__device__ __forceinline__ float rowmax(const f32x16&p0,const f32x16&p1){
  float a=max3f(p0[0],p0[1],p1[0]),b=max3f(p0[2],p0[3],p1[1]);a=max3f(a,p1[2],p1[3]);
  #pragma unroll
  for(int r=4;r<16;r+=4){a=max3f(a,p0[r],p0[r+1]);b=max3f(b,p0[r+2],p0[r+3]);a=max3f(a,p1[r],p1[r+1]);b=max3f(b,p1[r+2],p1[r+3]);}
  const float m=max2f(a,b);
  auto rr=__builtin_amdgcn_permlane32_swap(__float_as_uint(m),__float_as_uint(m),false,false);
  return max2f(__uint_as_float(rr[0]),__uint_as_float(rr[1]));
}
__device__ __forceinline__ void pv(f32x16*o,int vb,bf16x8 pa0,bf16x8 pa1,bf16x8 pa2,bf16x8 pa3){
  #pragma unroll
  for(int d0=0;d0<2;++d0){s16x4 lo[4],hi[4];
    #pragma unroll
    for(int ks=0;ks<4;++ks){
      asm volatile("ds_read_b64_tr_b16 %0,%1 offset:%c2":"=&v"(lo[ks]):"v"(vb),"i"(d0*4096+ks*1024):"memory");
      asm volatile("ds_read_b64_tr_b16 %0,%1 offset:%c2":"=&v"(hi[ks]):"v"(vb),"i"(d0*4096+ks*1024+512):"memory");}
    asm volatile("s_waitcnt lgkmcnt(0)":::"memory");SBAR();
    #define PK(k) (bf16x8){lo[k][0],lo[k][1],lo[k][2],lo[k][3],hi[k][0],hi[k][1],hi[k][2],hi[k][3]}
    o[d0]=__builtin_amdgcn_mfma_f32_32x32x16_bf16(pa0,PK(0),o[d0],0,0,0);
    o[d0]=__builtin_amdgcn_mfma_f32_32x32x16_bf16(pa1,PK(1),o[d0],0,0,0);
    o[d0]=__builtin_amdgcn_mfma_f32_32x32x16_bf16(pa2,PK(2),o[d0],0,0,0);
    o[d0]=__builtin_amdgcn_mfma_f32_32x32x16_bf16(pa3,PK(3),o[d0],0,0,0);
    #undef PK
  }
}

#ifndef ATTN_STORE16
#define ATTN_STORE16(p,v) (*(u32x4*)(p)=(v))
#endif
template<int THRL> __device__ __forceinline__ void attn_unit(int b,int h,int qb,const bf16*Q,const bf16*__restrict__ K,const bf16*__restrict__ V,bf16*O,char*shm,lds_fptr kbl){
  int tid=threadIdx.x; asm volatile("":"+v"(tid)); const int lane=tid&63,r32=lane&31,hi=lane>>5; const int wid=__builtin_amdgcn_readfirstlane(tid>>6);
  const long rowbase=(long)b*SEQ; const int q0=qb*QB;
  const bf16*Qw=Q+(rowbase+q0+wid*QBLK)*DM+h*D;
  const bf16*Kh=K+rowbase*DM+h*D,*Vh=V+rowbase*DM+h*D;
  const unsigned lds0=(unsigned)(uintptr_t)shm;
  float*wsf=(float*)(shm+LDS_WS)+wid*64;
  const bf16*ksrc=Kh+(long)lane*DM+wid*8;
  const bf16*vsrc=Vh+(long)(16*(wid&3)+(lane>>2))*DM+(wid>>2)*32+(lane&3)*8;
  const unsigned kdst=lds0+LDS_K+wid*1024, vdst=lds0+LDS_V+wid*1024;
  #define DMA_K(t,slot) glds16(ksrc+(long)(t)*KVBLK*DM,(unsigned)__builtin_amdgcn_readfirstlane(kdst+(slot)))
  #define DMA_V(t,slot) glds16(vsrc+(long)(t)*KVBLK*DM,(unsigned)__builtin_amdgcn_readfirstlane(vdst+(slot)))
  const int vb0=(int)(lds0+LDS_V)+((lane>>4)&1)*32+(lane&3)*8+(4*hi+((lane&15)>>2))*64;
  const char*Kbase=shm+LDS_K; bf16x8 kf[8];
  const lds_cptr shm3=(lds_cptr)shm; const lds_cptr kp0=shm3+LDS_K+hi*1024+r32*16; const lds_cptr vp0=shm3+LDS_V+((lane>>4)&1)*32+(lane&3)*8+(4*hi+((lane&15)>>2))*64;
  const int NT=(q0+QB)/KVBLK;
  DMA_K(0,0);DMA_V(0,0);DMA_K(1,SLOTB);
  bf16x8 qr[4];
  #pragma unroll
  for(int d0=0;d0<4;++d0)qr[d0]=*reinterpret_cast<const bf16x8*>(&Qw[(long)r32*DM+d0*16+hi*8]);
  float mhat=0.f,l_reg=0.f;f32x16 o[2];o[0]=f32x16{};o[1]=f32x16{};
  const lds_fptr kbh=kbl+4*hi;
  #define KBINIT(C0,C1,t) do{ const lds_fptr kb_=kbh+(t)*64; _Pragma("unroll") for(int g_=0;g_<4;++g_){ const f32x4_t a_=*(const __attribute__((address_space(3))) f32x4_t*)(kb_+8*g_), b_=*(const __attribute__((address_space(3))) f32x4_t*)(kb_+32+8*g_); _Pragma("unroll") for(int i_=0;i_<4;++i_){C0[4*g_+i_]=a_[i_]-mhat;C1[4*g_+i_]=b_[i_]-mhat;} } }while(0)
  const int qrel=wid*QBLK+r32;
  #define CMASK(P0,P1,t) do{int jb_=(t)-(NT-4); if(jb_>=0)cmask(P0,P1,jb_,qrel,hi);}while(0)
  bool resc=false;
  #define START(P0,P1) do{ const float rm=rowmax(P0,P1); resc=false; \
    { const float dl=rm; mhat=fadd_s(mhat,dl); \
      _Pragma("unroll") for(int r=0;r<16;++r){P0[r]=fsub_s(P0[r],dl);P1[r]=fsub_s(P1[r],dl);} } \
    _Pragma("unroll") for(int r=0;r<16;++r)P0[r]=__builtin_amdgcn_exp2f(P0[r]); }while(0)
  #define RESC() do{ if(resc){ asm volatile("s_waitcnt lgkmcnt(0)":::"memory"); \
      _Pragma("unroll") for(int d_=0;d_<2;++d_) _Pragma("unroll") for(int r=0;r<16;++r)o[d_][r]*=wsf[crow(r,hi)]; } }while(0)
  f32x16 pA0,pA1,pB0,pB1;
  int sl_prev=0,sl_cur=0,sl_next=SLOTB;
  #define ROT() do{sl_prev=sl_cur;sl_cur=sl_next;sl_next=(sl_next==(NSLOT-1)*SLOTB)?0:sl_next+SLOTB;}while(0)
  DMA_K(2,2*SLOTB);
  WAIT_BAR(3);
  KBINIT(pA0,pA1,0); qkt(pA0,pA1,Kbase,qr,r32,hi);asm volatile("s_nop 15\n\ts_nop 7":"+v"(pA0),"+v"(pA1));CMASK(pA0,pA1,0);
  START(pA0,pA1);
  _Pragma("unroll") for(int r=0;r<16;++r)pA1[r]=__builtin_amdgcn_exp2f(pA1[r]);
  WAIT_BAR(0);
  DMA_K(3,0);DMA_V(1,SLOTB);
  ROT();
  kload8(kf,kp0+sl_cur);
  WAIT_BAR(2);
  s16x4 vlo[8],vhi[8]; u32x4 pw0,pw1,pw2,pw3;
  #define PKW(P,B) cvtpk_s(P[B],P[B+1])
  #define PAF(k) __builtin_bit_cast(bf16x8,pw##k)
  #define VFR(i) (bf16x8){vlo[i][0],vlo[i][1],vlo[i][2],vlo[i][3],vhi[i][0],vhi[i][1],vhi[i][2],vhi[i][3]}
  #define PIN(x) asm volatile("":"+v"(x))
  #define MX3(a,b,c) __builtin_fmaxf(__builtin_fmaxf((a),(b)),(c))
  #define GAPA(MF,A0,A1,A2,A3,W0,W1,PW) do{ MF; sacc+=A0; sacc+=A1; sacc+=A2; sacc+=A3; PIN(sacc); W0; W1; PIN(PW); SBAR(); }while(0)
  #define EX(v) __builtin_amdgcn_exp2f(v)
  #define GAPB(MF,X,B) do{ MF; X[B]=EX(X[B]); X[B+1]=EX(X[B+1]); X[B+2]=EX(X[B+2]); X[B+3]=EX(X[B+3]); PIN(X); SBAR(); }while(0)
  #define VRD(i) do{ vlo[i]=vtr(vp_+(((i)>>2)*4096+((i)&3)*1024)); vhi[i]=vtr(vp_+(((i)>>2)*4096+((i)&3)*1024+512)); }while(0)
  #define KRD(G,j) do{ if(G){ kload2(kf,kp0+sl_next,j); SBAR(); } }while(0)
  #define STEP(C0,C1,P0,P1,t,GK,GV,GL) do{ KBINIT(C0,C1,t); SBAR(); \
    const lds_cptr vp_=vp0+sl_prev; \
    VRD(0); SBAR(); float sacc=(P0[0]+P0[1]); \
    GAPA(C0=__builtin_amdgcn_mfma_f32_32x32x16_bf16(kf[0],qr[0],C0,0,0,0), P0[2],P0[3],P0[4],P0[5],     pw0[0]=PKW(P0,0), pw0[1]=PKW(P0,2), pw0); \
    VRD(4); SBAR(); GAPA(C1=__builtin_amdgcn_mfma_f32_32x32x16_bf16(kf[1],qr[0],C1,0,0,0), P0[6],P0[7],P0[8],P0[9],     pw0[2]=PKW(P0,4), pw0[3]=PKW(P0,6), pw0); \
    VRD(1); SBAR(); GAPA(C0=__builtin_amdgcn_mfma_f32_32x32x16_bf16(kf[2],qr[1],C0,0,0,0),   P0[10],P0[11],P0[12],P0[13], pw1[0]=PKW(P0,8), pw1[1]=PKW(P0,10), pw1); \
    VRD(5); SBAR(); GAPA(C1=__builtin_amdgcn_mfma_f32_32x32x16_bf16(kf[3],qr[1],C1,0,0,0),   P0[14],P0[15],P1[0],P1[1],   pw1[2]=PKW(P0,12),pw1[3]=PKW(P0,14), pw1); \
    VRD(2); SBAR(); GAPA(C0=__builtin_amdgcn_mfma_f32_32x32x16_bf16(kf[4],qr[2],C0,0,0,0),   P1[2],P1[3],P1[4],P1[5],     pw2[0]=PKW(P1,0), pw2[1]=PKW(P1,2), pw2); \
    VRD(6); SBAR(); GAPA(C1=__builtin_amdgcn_mfma_f32_32x32x16_bf16(kf[5],qr[2],C1,0,0,0),   P1[6],P1[7],P1[8],P1[9],     pw2[2]=PKW(P1,4), pw2[3]=PKW(P1,6), pw2); \
    VRD(3); SBAR(); GAPA(C0=__builtin_amdgcn_mfma_f32_32x32x16_bf16(kf[6],qr[3],C0,0,0,0),   P1[10],P1[11],P1[12],P1[13], pw3[0]=PKW(P1,8), pw3[1]=PKW(P1,10), pw3); \
    VRD(7); SBAR(); GAPA(C1=__builtin_amdgcn_mfma_f32_32x32x16_bf16(kf[7],qr[3],C1,0,0,0),   P1[14],P1[15],0.f,0.f,       pw3[2]=PKW(P1,12),pw3[3]=PKW(P1,14), pw3); \
    l_reg+=sacc; \
    if(GK){DMA_K((t)+3,sl_cur);} if(GV){DMA_V((t)+1,sl_next);} \
    CMASK(C0,C1,t); \
    { float a=MX3(C0[0],C0[1],C1[0]),b=MX3(C0[2],C0[3],C1[1]); a=MX3(a,C1[2],C1[3]); \
      _Pragma("unroll") for(int r=4;r<16;r+=4){a=MX3(a,C0[r],C0[r+1]);b=MX3(b,C0[r+2],C0[r+3]);a=MX3(a,C1[r],C1[r+1]);b=MX3(b,C1[r+2],C1[r+3]);} \
      float rm=__builtin_fmaxf(a,b); { auto rr=__builtin_amdgcn_permlane32_swap(__float_as_uint(rm),__float_as_uint(rm),false,false); rm=__builtin_fmaxf(__uint_as_float(rr[0]),__uint_as_float(rr[1])); } \
      resc=false; \
      if(__builtin_expect(__any(rm>(float)THRL),0)){ const float dl=__builtin_fmaxf(rm,0.f); mhat+=dl; \
        _Pragma("unroll") for(int r=0;r<16;++r){C0[r]-=dl;C1[r]-=dl;} \
        const float f=__builtin_amdgcn_exp2f(-dl); l_reg*=f; if(hi==0)wsf[r32]=f; resc=true; } } \
    SBAR(); \
    GAPB(o[0]=__builtin_amdgcn_mfma_f32_32x32x16_bf16(PAF(0),VFR(0),o[0],0,0,0), C0,0); \
    GAPB(o[1]=__builtin_amdgcn_mfma_f32_32x32x16_bf16(PAF(0),VFR(4),o[1],0,0,0), C0,4); \
    KRD(GL,0); GAPB(o[0]=__builtin_amdgcn_mfma_f32_32x32x16_bf16(PAF(1),VFR(1),o[0],0,0,0), C0,8); \
    KRD(GL,1); GAPB(o[1]=__builtin_amdgcn_mfma_f32_32x32x16_bf16(PAF(1),VFR(5),o[1],0,0,0), C0,12); \
    KRD(GL,2); GAPB(o[0]=__builtin_amdgcn_mfma_f32_32x32x16_bf16(PAF(2),VFR(2),o[0],0,0,0), C1,0); \
    KRD(GL,3); GAPB(o[1]=__builtin_amdgcn_mfma_f32_32x32x16_bf16(PAF(2),VFR(6),o[1],0,0,0), C1,4); \
    GAPB(o[0]=__builtin_amdgcn_mfma_f32_32x32x16_bf16(PAF(3),VFR(3),o[0],0,0,0), C1,8); \
    GAPB(o[1]=__builtin_amdgcn_mfma_f32_32x32x16_bf16(PAF(3),VFR(7),o[1],0,0,0), C1,12); \
    }while(0)
  int t=1;
  #undef CMASK
  #define CMASK(P0,P1,t) do{}while(0)
  for(;t+5<NT;t+=2){
    STEP(pB0,pB1,pA0,pA1,t,true,true,true);     WAIT_BAR(2); RESC(); ROT();
    STEP(pA0,pA1,pB0,pB1,t+1,true,true,true);   WAIT_BAR(2); RESC(); ROT();
  }
  #undef CMASK
  #define CMASK(P0,P1,t) do{int jb_=(t)-(NT-4); if(jb_>=0)cmask(P0,P1,jb_,qrel,hi);}while(0)
  #define ENDW(tt) do{ if((tt)+3<NT){WAIT_BAR(2);} else if((tt)+2<NT){WAIT_BAR(1);} else {WAIT_BAR(0);} }while(0)
  for(;t+1<NT;t+=2){
    STEP(pB0,pB1,pA0,pA1,t,(t+3<NT),(t+1<NT),(t+1<NT));       ENDW(t);   RESC(); ROT();
    STEP(pA0,pA1,pB0,pB1,t+1,(t+4<NT),(t+2<NT),(t+2<NT));     ENDW(t+1); RESC(); ROT();
  }
  STEP(pB0,pB1,pA0,pA1,NT-1,false,false,false); RESC();
  { float sacc=pB0[0]+pB0[1]; _Pragma("unroll") for(int r=2;r<16;++r)sacc+=pB0[r]; _Pragma("unroll") for(int r=0;r<16;++r)sacc+=pB1[r]; l_reg+=sacc;
    pw0=(u32x4){PKW(pB0,0),PKW(pB0,2),PKW(pB0,4),PKW(pB0,6)};pw1=(u32x4){PKW(pB0,8),PKW(pB0,10),PKW(pB0,12),PKW(pB0,14)};pw2=(u32x4){PKW(pB1,0),PKW(pB1,2),PKW(pB1,4),PKW(pB1,6)};pw3=(u32x4){PKW(pB1,8),PKW(pB1,10),PKW(pB1,12),PKW(pB1,14)};
    SBAR(); pv(o,vb0+sl_cur,PAF(0),PAF(1),PAF(2),PAF(3)); }
  #undef PKW
  #undef PAF
  #undef VFR
  #undef PIN
  #undef MX3
  #undef GAPA
  #undef GAPB
  #undef EX
  #undef VRD
  #undef KRD
  #undef STEP
  #undef ENDW
  {auto rr=__builtin_amdgcn_permlane32_swap(__float_as_uint(l_reg),__float_as_uint(l_reg),false,false);l_reg=__uint_as_float(rr[0])+__uint_as_float(rr[1]);}
  if(hi==0)wsf[32+r32]=l_reg;asm volatile("s_waitcnt lgkmcnt(0)":::"memory");
  float rli[16];
  #pragma unroll
  for(int r=0;r<16;++r)rli[r]=__builtin_amdgcn_rcpf(wsf[32+crow(r,hi)]);
  bf16*Ow=O+(rowbase+q0+wid*QBLK)*DM+h*D;
  { bf16*stg=(bf16*)(shm+LDS_OST)+wid*2048;
    #pragma unroll
    for(int r=0;r<16;++r){const int orow=crow(r,hi);
      #pragma unroll
      for(int d0=0;d0<2;++d0)stg[orow*64+d0*32+r32]=__float2bfloat16(o[d0][r]*rli[r]);}
    asm volatile("s_waitcnt lgkmcnt(0)":::"memory");
    #pragma unroll
    for(int i=0;i<4;++i){const int row=i*8+(lane>>3),ch=lane&7; const u32x4 v=*(const u32x4*)(stg+row*64+ch*8); ATTN_STORE16(Ow+(long)row*DM+ch*8,v);} }
  asm volatile("s_waitcnt lgkmcnt(0)\n\ts_barrier":::"memory");
  #undef DMA_K
  #undef DMA_V
  #undef CMASK
  #undef START
  #undef RESC
  #undef ROT
  #undef KBINIT
}
constexpr int ATTN_LDS_BYTES=LDS_BYTES;
struct AttnTensors { const bf16* Q; const bf16* K; const bf16* V; bf16* O; };
struct AttnUnit { int bh; int qb; };
struct StaticOrder {
  int vcu;
  __device__ __forceinline__ explicit StaticOrder(int grid,int block):vcu((block%8)*(grid/8)+block/8){}
  __device__ __forceinline__ bool next(int i,AttnUnit&u)const{ if(i>=8)return false; const int s=4*(vcu&1)+(i>>1); u.bh=vcu>>1; u.qb=(i&1)?15-s:s; return true; }
  __device__ __forceinline__ void a_ready(const AttnUnit&)const{}
  __device__ __forceinline__ void done(const AttnUnit&)const{}
};
template<class Sched,int THRL=8> __device__ __forceinline__ void attn_phase(char*lds,const AttnTensors&T,const Sched&S,lds_fptr kbl){
  AttnUnit u;
  for(int i=0;S.next(i,u);++i){ S.a_ready(u); attn_unit<THRL>(u.bh/NHEAD,u.bh%NHEAD,u.qb,T.Q,T.K,T.V,T.O,lds,kbl); S.done(u); }
}
#undef SBAR
#undef WAIT_BAR
}
#define GAS __attribute__((address_space(1)))
#define LAS __attribute__((address_space(3)))
typedef unsigned short bf16;
typedef unsigned v4u __attribute__((ext_vector_type(4)));
typedef float f32x4 __attribute__((ext_vector_type(4)));
typedef short bf16x8 __attribute__((ext_vector_type(8)));
typedef GAS unsigned gu32;
typedef GAS unsigned long long gu64;
#define RLX_AGENT __ATOMIC_RELAXED, __HIP_MEMORY_SCOPE_AGENT
#define LDS_WAIT() asm volatile("s_waitcnt lgkmcnt(0)" ::: "memory")
#define VM_WAIT() asm volatile("s_waitcnt vmcnt(0)" ::: "memory")
__device__ __forceinline__ unsigned long long rt() { return __builtin_amdgcn_s_memrealtime(); }
__device__ __forceinline__ unsigned f2bf(float f) { unsigned u = __builtin_bit_cast(unsigned, f); return (u + 0x7fffu + ((u >> 16) & 1u)) >> 16; }
__device__ __forceinline__ unsigned pk2(float lo, float hi) { return f2bf(lo) | (f2bf(hi) << 16); }

#define XB_TMO      128
#define XB_XCNT(j)  (256  + 64 * (j))
#define XB_XSUB(j)  (1280 + 64 * (j))
#define XB_XGEN(j)  (2304 + 64 * (j))
#define XB_TOP      3328
#define XB_TOPGEN   3392
#define XCD_BAR_WORDS 3456
#define XB_SPIN_CAP (1u << 18)

__device__ __forceinline__ unsigned xb_ld(unsigned* p)              { return __hip_atomic_load(p, __ATOMIC_RELAXED, __HIP_MEMORY_SCOPE_AGENT); }
__device__ __forceinline__ unsigned xb_add(unsigned* p, unsigned v) { return __hip_atomic_fetch_add(p, v, __ATOMIC_RELAXED, __HIP_MEMORY_SCOPE_AGENT); }
__device__ __forceinline__ unsigned xb_xcc_id() { return (unsigned)__builtin_amdgcn_s_getreg((3 << 11) | 20) & 0xFu; }
#define XB_SPIN(cond, bar) do { unsigned _sp = 0; while (cond) { __builtin_amdgcn_s_sleep(1); \
    if ((++_sp & 255u) == 0u) { if (xb_ld(&(bar)[XB_TMO])) break; if (_sp > XB_SPIN_CAP) { atomicAdd(&(bar)[XB_TMO], 1u); break; } } } } while (0)

struct XcdBarrier {
    unsigned* bar; unsigned x;
    volatile LAS unsigned* st;
};

__device__ __forceinline__ XcdBarrier xcd_barrier_post(unsigned* bar, volatile LAS unsigned* st) {
    XcdBarrier b; b.bar = bar; b.x = xb_xcc_id(); b.st = st;
    if (threadIdx.x == 0) (void)xb_add(&bar[XB_XCNT(b.x)], 1u);
    return b;
}
__device__ __forceinline__ void xcd_barrier_complete(unsigned* bar, unsigned x, unsigned& nloc, unsigned& nx) {
    const unsigned G = gridDim.x * gridDim.y * gridDim.z;
    unsigned sum, cnt, mine, sp = 0u;
    for (;;) {
        sum = 0u; cnt = 0u; mine = 0u;
#pragma unroll
        for (unsigned j = 0; j < 16; ++j) { const unsigned c = xb_ld(&bar[XB_XCNT(j)]); sum += c; cnt += (c > 0u) ? 1u : 0u; mine = (j == x) ? c : mine; }
        if (sum == G) break;
        __builtin_amdgcn_s_sleep(1);
        if ((++sp & 255u) == 0u) { if (xb_ld(&bar[XB_TMO])) break; if (sp > XB_SPIN_CAP) { atomicAdd(&bar[XB_TMO], 1u); break; } }
    }
    nloc = mine > 0u ? mine : 1u; nx = cnt > 0u ? cnt : 1u;
}

__device__ __forceinline__ void xcd_barrier(const XcdBarrier& b) {
    asm volatile("s_waitcnt vmcnt(0)" ::: "memory");
    __syncthreads();
    if (threadIdx.x == 0) {
        unsigned* bar = b.bar; const unsigned myx = xb_xcc_id();
        __builtin_amdgcn_s_waitcnt(0);
        unsigned nloc = b.st[0], nx = b.st[1];
        if (nloc == 0u) { xcd_barrier_complete(bar, myx, nloc, nx); b.st[0] = nloc; b.st[1] = nx; }
        const unsigned old = xb_add(&bar[XB_XSUB(myx)], 1u);
        const unsigned gen = old / nloc;
        if (old + 1u == (gen + 1u) * nloc) {
            __builtin_amdgcn_fence(__ATOMIC_RELEASE, "agent");
            asm volatile("s_waitcnt vmcnt(0)" ::: "memory");
            const unsigned og = xb_add(&bar[XB_TOP], 1u);
            const unsigned tg = og / nx;
            if (og + 1u == (tg + 1u) * nx) xb_add(&bar[XB_TOPGEN], 1u);
            else XB_SPIN(xb_ld(&bar[XB_TOPGEN]) == tg, bar);
            __builtin_amdgcn_fence(__ATOMIC_ACQUIRE, "agent");
            xb_add(&bar[XB_XGEN(myx)], 1u);
            asm volatile("s_waitcnt vmcnt(0)" ::: "memory");
        } else {
            XB_SPIN(xb_ld(&bar[XB_XGEN(myx)]) == gen, bar);
            __builtin_amdgcn_fence(__ATOMIC_ACQUIRE, "agent");
            asm volatile("s_waitcnt vmcnt(0)" ::: "memory");
        }
    }
    __syncthreads();
}

constexpr int NWAVES = 8, NTHR = 512;
constexpr int NB = 8, SEQ = 4096, D = 1024, M = NB * SEQ, NH = 16;
constexpr int NEXP = 16384, NSEL = 128;
constexpr float LN_EPS = 1e-5f;
constexpr float DN_ALPHA = 1.41421356237309515f;
constexpr int NAI = 3088, NAI_PAD = 3328;

constexpr size_t MiB = 1u << 20;
constexpr size_t WS_CTL = 0, CTL_ZERO_BYTES = 1 * MiB;
constexpr size_t WS_MOD = 512 * 1024;
constexpr size_t WS_SKB = 1 * MiB;
constexpr size_t WS_LOGF = 2 * MiB;
constexpr size_t WS_WCI = 8 * MiB, WS_WCO = 12 * MiB, WS_WAI = 14 * MiB, WS_WAO = 21 * MiB, WS_WPQ = 23 * MiB;
constexpr size_t WS_EXP = 32 * MiB;
constexpr size_t WS_HB = 160 * MiB;
constexpr size_t WS_BIG = 224 * MiB;
constexpr size_t WS_IDX = 416 * MiB, WS_GATE = 432 * MiB, WS_END = 448 * MiB;
constexpr int CW_BAR = 4096;

constexpr int RING_OFF = 0, RING_BYTES = 131072;
constexpr int LDSCTL_OFF = RING_BYTES, MISC_OFF = LDSCTL_OFF + 320;
constexpr int LDS_BYTES = 147456;
constexpr int KB_OFF = 98304;

#ifndef PHM
#define PHM 0xFFFF
#endif
struct Args { const float* in[27]; float* out; unsigned char* ws; };

__device__ __forceinline__ float wave_sum(float v) {
#pragma unroll
    for (int o = 1; o < 64; o <<= 1) v += __shfl_xor(v, o);
    return v;
}
__device__ __forceinline__ float bf_lo(unsigned w) { return __uint_as_float(w << 16); }
__device__ __forceinline__ float bf_hi(unsigned w) { return __uint_as_float(w & 0xffff0000u); }
__device__ __forceinline__ float sigmoidf_(float x) { return 1.f / (1.f + __expf(-x)); }

namespace pg8 {
struct EpiGlu {
    static constexpr bool PERM = true, AFTER_DRAIN = false;
    bf16_t* O; const float* bias;
    __device__ __forceinline__ void operator()(const f32x4 (&acc)[2][2][4][2], const Unit& u, int wr, int wc, int fr, int fq) const {
        const int row0 = u.pm * BM + wr * 64 + fr; const int ocol = u.pn * 128 + wc * 32 + 8 * fq;
        f32x4 bl[2], bg[2];
#pragma unroll
        for (int n = 0; n < 2; ++n) { bl[n] = *(const f32x4*)(bias + ocol + 4 * n); bg[n] = *(const f32x4*)(bias + 1024 + ocol + 4 * n); }
#pragma unroll
        for (int ai = 0; ai < 2; ++ai)
#pragma unroll
            for (int m = 0; m < 4; ++m) {
                float v[8];
#pragma unroll
                for (int n = 0; n < 2; ++n)
#pragma unroll
                    for (int i = 0; i < 4; ++i) { const float l = acc[ai][0][m][n][i] + bl[n][i], g = acc[ai][1][m][n][i] + bg[n][i]; v[4 * n + i] = l / (1.f + __expf(-g)); }
                u32x4 w; w.x = cvt_pk_bf16(v[0], v[1]); w.y = cvt_pk_bf16(v[2], v[3]); w.z = cvt_pk_bf16(v[4], v[5]); w.w = cvt_pk_bf16(v[6], v[7]);
                *(u32x4*)(O + (size_t)(row0 + ai * HALF + m * 16) * 1024 + ocol) = w;
            }
    }
};
struct EpiQkvf {
    static constexpr bool PERM = true, AFTER_DRAIN = false;
    EpiBf16<0> inner; float* logf_t; const float* bias;
    __device__ __forceinline__ void operator()(const f32x4 (&acc)[2][2][4][2], const Unit& u, int wr, int wc, int fr, int fq) const {
        if (u.pn < 12) { inner(acc, u, wr, wc, fr, fq); return; }
        if (wc == 0 && fq < 2) {
            const int row0 = u.pm * BM + wr * 64 + fr;
#pragma unroll
            for (int ai = 0; ai < 2; ++ai)
#pragma unroll
                for (int m = 0; m < 4; ++m) { const int row = row0 + ai * HALF + m * 16; const int b = row >> 12, s = row & 4095;
#pragma unroll
                    for (int n = 0; n < 2; ++n)
#pragma unroll
                        for (int i = 0; i < 4; ++i) { const int col = 8 * fq + 4 * n + i; const float v = acc[ai][0][m][n][i] + bias[3072 + col];
                            const float lf = fminf(v, 0.f) - log1pf(__expf(-fabsf(v)));
                            logf_t[((size_t)(b * 16 + col) << 12) + s] = lf; } }
        }
    }
};
}

__device__ __forceinline__ void transpose_item(const float* W, int K, int ldw, bf16* WT, int k0, int n0, int dst_row0, LAS float* scr, int lane) {
#pragma unroll 8
    for (int i = 0; i < 32; ++i) { const int kk = 2 * i + (lane >> 5); scr[kk * 33 + (lane & 31)] = W[(size_t)(k0 + kk) * ldw + n0 + (lane & 31)]; }
    LDS_WAIT(); asm volatile("" ::: "memory");
    const int c = lane & 7;
#pragma unroll
    for (int j = 0; j < 4; ++j) { const int n = (lane >> 3) + 8 * j; const LAS float* s = scr + (8 * c) * 33 + n;
        v4u o; o.x = pk2(s[0 * 33], s[1 * 33]); o.y = pk2(s[2 * 33], s[3 * 33]); o.z = pk2(s[4 * 33], s[5 * 33]); o.w = pk2(s[6 * 33], s[7 * 33]);
        *(GAS v4u*)(WT + (size_t)(dst_row0 + n) * K + k0 + 8 * c) = o; }
    LDS_WAIT(); asm volatile("" ::: "memory");
}

struct RowVec { float v[16]; };
__device__ __forceinline__ void load16f(const float* p, int lane, float* v) {
    const f32x4 a = *(const f32x4*)(p + 8 * lane), b = *(const f32x4*)(p + 8 * lane + 4), c = *(const f32x4*)(p + 512 + 8 * lane), d = *(const f32x4*)(p + 512 + 8 * lane + 4);
#pragma unroll
    for (int i = 0; i < 4; ++i) { v[i] = a[i]; v[4 + i] = b[i]; v[8 + i] = c[i]; v[12 + i] = d[i]; }
}
__device__ __forceinline__ void store16f(float* p, int lane, const float* v) {
    *(f32x4*)(p + 8 * lane) = (f32x4){v[0], v[1], v[2], v[3]}; *(f32x4*)(p + 8 * lane + 4) = (f32x4){v[4], v[5], v[6], v[7]};
    *(f32x4*)(p + 512 + 8 * lane) = (f32x4){v[8], v[9], v[10], v[11]}; *(f32x4*)(p + 512 + 8 * lane + 4) = (f32x4){v[12], v[13], v[14], v[15]};
}
__device__ __forceinline__ void store16bf(bf16* p, int lane, const float* v) {
    v4u a, b; a.x = pk2(v[0], v[1]); a.y = pk2(v[2], v[3]); a.z = pk2(v[4], v[5]); a.w = pk2(v[6], v[7]);
    b.x = pk2(v[8], v[9]); b.y = pk2(v[10], v[11]); b.z = pk2(v[12], v[13]); b.w = pk2(v[14], v[15]);
    *(v4u*)(p + 8 * lane) = a; *(v4u*)(p + 512 + 8 * lane) = b;
}
__device__ __forceinline__ void resid_ln_row(const float* xin_row, const float* y, const float* modg  , const float* lng, const float* lnb,
                                             float* xout_row, bf16* hb_row, const float* modn  , int lane) {
    float x[16], g[16];
    load16f(xin_row, lane, x); load16f(modg, lane, g);
    float s = 0.f;
#pragma unroll
    for (int i = 0; i < 16; ++i) { x[i] = DN_ALPHA * x[i] + g[i] * y[i]; s += x[i]; }
    const float mean = wave_sum(s) * (1.f / D); float q = 0.f;
#pragma unroll
    for (int i = 0; i < 16; ++i) { x[i] -= mean; q += x[i] * x[i]; }
    const float rstd = 1.f / sqrtf(wave_sum(q) * (1.f / D) + LN_EPS);
    load16f(lng, lane, g);
#pragma unroll
    for (int i = 0; i < 16; ++i) x[i] = x[i] * rstd * g[i];
    load16f(lnb, lane, g);
#pragma unroll
    for (int i = 0; i < 16; ++i) x[i] += g[i];
    store16f(xout_row, lane, x);
    if (modn) {
        load16f(modn + 1024, lane, g);
#pragma unroll
        for (int i = 0; i < 16; ++i) x[i] = x[i] * (1.f + g[i]);
        load16f(modn, lane, g);
#pragma unroll
        for (int i = 0; i < 16; ++i) x[i] += g[i];
        store16bf(hb_row, lane, x);
    }
}

__device__ __forceinline__ unsigned f2key(float f) { const unsigned u = __float_as_uint(f); return u ^ ((unsigned)((int)u >> 31) | 0x80000000u); }
__device__ __forceinline__ float key2f(unsigned k) { const unsigned u = (k & 0x80000000u) ? (k ^ 0x80000000u) : ~k; return __uint_as_float(u); }
#define CE_DESC(x, y) do { const unsigned mx_ = (x) > (y) ? (x) : (y), mn_ = (x) > (y) ? (y) : (x); (x) = mx_; (y) = mn_; } while (0)
template <int O> __device__ __forceinline__ void sort16_desc(unsigned (&a)[64]) {
#pragma unroll
    for (int lk = 1; lk <= 4; ++lk)
#pragma unroll
        for (int lj = lk - 1; lj >= 0; --lj)
#pragma unroll
            for (int i = 0; i < 16; ++i) { const int k = 1 << lk, j = 1 << lj, l = i ^ j;
                if (l > i) { if ((i & k) == 0 || lk == 4) CE_DESC(a[O + i], a[O + l]); else CE_DESC(a[O + l], a[O + i]); } }
}
template <int O> __device__ __forceinline__ void bmerge16_desc(unsigned (&a)[64]) {
#pragma unroll
    for (int lj = 3; lj >= 0; --lj)
#pragma unroll
        for (int i = 0; i < 16; ++i) { const int j = 1 << lj, l = i ^ j; if (l > i) CE_DESC(a[O + i], a[O + l]); }
}
template <int OA, int OB> __device__ __forceinline__ void topmerge16(unsigned (&a)[64]) {
#pragma unroll
    for (int i = 0; i < 16; ++i) { const unsigned x = a[OA + i], y = a[OB + 15 - i]; a[OA + i] = x > y ? x : y; }
    bmerge16_desc<OA>(a);
}
__device__ __forceinline__ void top16_of_64(unsigned (&a)[64]) {
    sort16_desc<0>(a); sort16_desc<16>(a); sort16_desc<32>(a); sort16_desc<48>(a);
    topmerge16<0, 16>(a); topmerge16<32, 48>(a); topmerge16<0, 32>(a);
}
__host__ __device__ constexpr bool pk_valid(int i, int j) { return (i + 1) * (j + 1) <= 16; }
__host__ __device__ constexpr int pk_pos(int i, int j) { int n = 0; for (int a = 0; a < 16; ++a) for (int b = 0; b < 16; ++b) { if (a == i && b == j) return n; if (pk_valid(a, b)) ++n; } return n; }
static_assert(pk_pos(15, 1) == 50, "50 candidate pairs");

template <int IJ> __device__ __forceinline__ void fill_cand(unsigned (&c)[64], const float (&v1)[16], const float (&v2)[16]) {
    if constexpr (IJ < 256) { constexpr int i = IJ >> 4, j = IJ & 15;
        if constexpr (pk_valid(i, j)) { constexpr int p = pk_pos(i, j); c[p] = (f2key(v1[i] + v2[j]) & ~0xFFu) | (unsigned)(i * 16 + j); }
        fill_cand<IJ + 1>(c, v1, v2); }
}
__device__ __forceinline__ void peer_half_top16(const bf16* pq_rows  , const bf16* sk  , int r32, int hi, unsigned (&L)[16]) {
    using attn_body::f32x16;
    f32x16 acc[4]; acc[0] = f32x16{}; acc[1] = f32x16{}; acc[2] = f32x16{}; acc[3] = f32x16{};
#pragma unroll
    for (int ks = 0; ks < 8; ++ks) {
        const bf16x8 bq = *(const bf16x8*)(pq_rows + (size_t)r32 * 2048 + ks * 16 + hi * 8);
#pragma unroll
        for (int kb = 0; kb < 4; ++kb) { const bf16x8 ak = *(const bf16x8*)(sk + (kb * 32 + r32) * 128 + ks * 16 + hi * 8);
            acc[kb] = __builtin_amdgcn_mfma_f32_32x32x16_bf16(ak, bq, acc[kb], 0, 0, 0); }
    }
    unsigned a[64];
#pragma unroll
    for (int kb = 0; kb < 4; ++kb)
#pragma unroll
        for (int r = 0; r < 16; ++r) a[kb * 16 + r] = (f2key(acc[kb][r]) & ~0x7Fu) | (unsigned)(kb * 32 + (r & 3) + 8 * (r >> 2) + 4 * hi);
    top16_of_64(a);
#pragma unroll
    for (int i = 0; i < 16; ++i) a[16 + i] = (unsigned)__shfl_xor((int)a[i], 32);
    topmerge16<0, 16>(a);
#pragma unroll
    for (int i = 0; i < 16; ++i) L[i] = a[i];
}
__device__ __forceinline__ unsigned byte_lookup(unsigned long long lo, unsigned long long hi8, unsigned i) {
    const unsigned long long s = (i & 8u) ? hi8 : lo; return (unsigned)(s >> ((i & 7u) * 8u)) & 0x7Fu;
}
__device__ __forceinline__ void peer_topk_item(const bf16* PQ, const bf16* SK  , unsigned* IDX, float* GATE, int tb, int head, int lane) {
    const int r32 = lane & 31, hi = lane >> 5; const int t0 = tb * 32;
    unsigned L1[16], L2[16];
    peer_half_top16(PQ + (size_t)t0 * 2048 + head * 256, SK, r32, hi, L1);
    peer_half_top16(PQ + (size_t)t0 * 2048 + head * 256 + 128, SK + 128 * 128, r32, hi, L2);
    float v1[16], v2[16]; unsigned long long p1lo = 0, p1hi = 0, p2lo = 0, p2hi = 0;
#pragma unroll
    for (int i = 0; i < 16; ++i) { v1[i] = key2f(L1[i] & ~0x7Fu); v2[i] = key2f(L2[i] & ~0x7Fu);
        const unsigned long long b1 = (unsigned long long)(L1[i] & 0x7Fu) << ((i & 7) * 8), b2 = (unsigned long long)(L2[i] & 0x7Fu) << ((i & 7) * 8);
        if (i < 8) { p1lo |= b1; p2lo |= b2; } else { p1hi |= b1; p2hi |= b2; } }
    unsigned c[64];
    fill_cand<0>(c, v1, v2);
#pragma unroll
    for (int i = 50; i < 64; ++i) c[i] = 0u;
    top16_of_64(c);
    float sc[16], e[16]; unsigned ex[16]; float sum = 0.f;
#pragma unroll
    for (int k = 0; k < 16; ++k) { const unsigned id = c[k] & 0xFFu; sc[k] = key2f(c[k] & ~0xFFu);
        ex[k] = byte_lookup(p1lo, p1hi, id >> 4) * 128u + byte_lookup(p2lo, p2hi, id & 15u); }
#pragma unroll
    for (int k = 0; k < 16; ++k) { e[k] = __expf(sc[k] - sc[0]); sum += e[k]; }
    const float rs = 1.f / sum;
    v4u i0, i1; f32x4 g0, g1;
    i0.x = hi ? ex[8] : ex[0]; i0.y = hi ? ex[9] : ex[1]; i0.z = hi ? ex[10] : ex[2]; i0.w = hi ? ex[11] : ex[3];
    i1.x = hi ? ex[12] : ex[4]; i1.y = hi ? ex[13] : ex[5]; i1.z = hi ? ex[14] : ex[6]; i1.w = hi ? ex[15] : ex[7];
    g0[0] = (hi ? e[8] : e[0]) * rs; g0[1] = (hi ? e[9] : e[1]) * rs; g0[2] = (hi ? e[10] : e[2]) * rs; g0[3] = (hi ? e[11] : e[3]) * rs;
    g1[0] = (hi ? e[12] : e[4]) * rs; g1[1] = (hi ? e[13] : e[5]) * rs; g1[2] = (hi ? e[14] : e[6]) * rs; g1[3] = (hi ? e[15] : e[7]) * rs;
    const size_t o = (size_t)(t0 + r32) * NSEL + head * 16 + hi * 8;
    *(v4u*)(IDX + o) = i0; *(v4u*)(IDX + o + 4) = i1; *(f32x4*)(GATE + o) = g0; *(f32x4*)(GATE + o + 4) = g1;
}

typedef __bf16 bf16x2_v __attribute__((ext_vector_type(2)));
__device__ __forceinline__ float dot2bf(unsigned a, unsigned b, float c) {
#if __has_builtin(__builtin_amdgcn_fdot2_f32_bf16)
    return __builtin_amdgcn_fdot2_f32_bf16(__builtin_bit_cast(bf16x2_v, a), __builtin_bit_cast(bf16x2_v, b), c, false);
#else
    return c + bf_lo(a) * bf_lo(b) + bf_hi(a) * bf_hi(b);
#endif
}
__device__ __forceinline__ float dot8(const v4u u, const v4u h, float c) { c = dot2bf(u.x, h.x, c); c = dot2bf(u.y, h.y, c); c = dot2bf(u.z, h.z, c); return dot2bf(u.w, h.w, c); }
__device__ __forceinline__ void axpy8(float* o, float a, const v4u v) {
    o[0] += a * bf_lo(v.x); o[1] += a * bf_hi(v.x); o[2] += a * bf_lo(v.y); o[3] += a * bf_hi(v.y);
    o[4] += a * bf_lo(v.z); o[5] += a * bf_hi(v.z); o[6] += a * bf_lo(v.w); o[7] += a * bf_hi(v.w);
}
__device__ __forceinline__ void peer_gather_token(const bf16* hrow, const unsigned* idxrow, const float* gaterow, const bf16* U, const bf16* V, int lane, float* out) {
    const v4u h0 = *(const v4u*)(hrow + 8 * lane), h1 = *(const v4u*)(hrow + 512 + 8 * lane);
    const unsigned idx_lo = idxrow[lane], idx_hi = idxrow[64 + lane];
#pragma unroll
    for (int i = 0; i < 16; ++i) out[i] = 0.f;
    const int hi = lane >> 5, g1 = (lane >> 4) & 1;
    const int e_lane = (lane & 3) + 4 * g1 + 8 * hi;
#pragma unroll 1
    for (int b = 0; b < 8; ++b) {
        const unsigned idxr = (b < 4) ? idx_lo : idx_hi; const int lb = (b & 3) * 16;
        const float gt = gaterow[b * 16 + e_lane];
        float p[16];
#pragma unroll
        for (int e = 0; e < 16; ++e) {
            const unsigned eid = (unsigned)__builtin_amdgcn_readlane((int)idxr, lb + e);
            const bf16* up = U + (size_t)eid * D;
            const v4u u0 = *(const v4u*)(up + 8 * lane), u1 = *(const v4u*)(up + 512 + 8 * lane);
            p[e] = dot8(u1, h1, dot8(u0, h0, 0.f));
        }
        float q8[8], q4[4];
#pragma unroll
        for (int k = 0; k < 8; ++k) { const float send = hi ? p[k] : p[k + 8], keep = hi ? p[k + 8] : p[k]; q8[k] = keep + __shfl_xor(send, 32); }
#pragma unroll
        for (int k = 0; k < 4; ++k) { const float send = g1 ? q8[k] : q8[k + 4], keep = g1 ? q8[k + 4] : q8[k]; q4[k] = keep + __shfl_xor(send, 16); }
#pragma unroll
        for (int k = 0; k < 4; ++k) { q4[k] += __shfl_xor(q4[k], 8); q4[k] += __shfl_xor(q4[k], 4); q4[k] += __shfl_xor(q4[k], 2); q4[k] += __shfl_xor(q4[k], 1); }
        const int ks = lane & 3;
        const float tot = ks == 0 ? q4[0] : ks == 1 ? q4[1] : ks == 2 ? q4[2] : q4[3];
        const float act = 0.5f * tot * (1.f + erff(tot * 0.70710678118654752f)) * gt;
#pragma unroll
        for (int e = 0; e < 16; ++e) {
            const unsigned eid = (unsigned)__builtin_amdgcn_readlane((int)idxr, lb + e);
            const float a = __uint_as_float((unsigned)__builtin_amdgcn_readlane((int)__float_as_uint(act), 16 * ((e >> 2) & 1) + 32 * (e >> 3) + (e & 3)));
            const bf16* vp = V + (size_t)eid * D;
            const v4u v0 = *(const v4u*)(vp + 8 * lane), v1 = *(const v4u*)(vp + 512 + 8 * lane);
            axpy8(out, a, v0); axpy8(out + 8, a, v1);
        }
    }
}

#define KINRAW(k) (((const unsigned long long volatile __attribute__((address_space(4)))*)__builtin_amdgcn_kernarg_segment_ptr())[k])
#define KIN(k) ((const float*)(const GAS float*)KINRAW(k))
__global__ void __launch_bounds__(NTHR, 2) trunk_fwd(Args args) {
    extern __shared__ __attribute__((aligned(16))) unsigned char lds[];
    LAS unsigned char* ldsl = (LAS unsigned char*)lds;
    volatile LAS unsigned* MISC = (volatile LAS unsigned*)(ldsl + MISC_OFF);
    const int G = gridDim.x; const int bx = blockIdx.x; const int vcu = (G % 8 == 0) ? (bx % 8) * (G / 8) + bx / 8 : bx;
    const int NGW = G * NWAVES;
#define PHASE_IDS int tid = threadIdx.x; asm volatile("" : "+v"(tid)); const int lane = tid & 63, wave = __builtin_amdgcn_readfirstlane(tid >> 6); const int gw = vcu * NWAVES + wave; (void)gw; (void)lane;
    gu32* ctl = (gu32*)((GAS unsigned char*)KINRAW(28) + WS_CTL);
    for (int u = threadIdx.x; u < (LDS_BYTES - LDSCTL_OFF) / 4; u += NTHR) ((LAS unsigned*)(ldsl + LDSCTL_OFF))[u] = 0u;
    __syncthreads();
    XcdBarrier bar = xcd_barrier_post((unsigned*)(ctl + CW_BAR), MISC + 8);
#define GRID_BAR() xcd_barrier(bar)

#define x_in KIN(0)
#define c_in KIN(1)
#define ada_mix_w KIN(2)
#define ada_mix_b KIN(3)
#define ln_mix_g KIN(4)
#define ln_mix_b KIN(5)
#define conv_in_w KIN(6)
#define conv_in_b KIN(7)
#define conv_dw_w KIN(8)
#define conv_dw_b KIN(9)
#define conv_ln_g KIN(10)
#define conv_ln_b KIN(11)
#define conv_out_w KIN(12)
#define conv_out_b KIN(13)
#define attn_in_w KIN(14)
#define attn_in_b KIN(15)
#define attn_out_w KIN(16)
#define attn_out_b KIN(17)
#define ada_ffn_w KIN(18)
#define ada_ffn_b KIN(19)
#define ln_ffn_g KIN(20)
#define ln_ffn_b KIN(21)
#define peer_query_w KIN(22)
#define peer_sk1 KIN(23)
#define peer_sk2 KIN(24)
#define peer_u KIN(25)
#define peer_v KIN(26)
#define X ((float*)(GAS float*)KINRAW(27))
#define WSP ((unsigned char*)(GAS unsigned char*)KINRAW(28))
#define MOD ((float*)(WSP + WS_MOD))
#define SKB ((bf16*)(WSP + WS_SKB))
#define LOGF ((float*)(WSP + WS_LOGF))
#define WCI ((bf16*)(WSP + WS_WCI))
#define WCO ((bf16*)(WSP + WS_WCO))
#define WAI ((bf16*)(WSP + WS_WAI))
#define WAO ((bf16*)(WSP + WS_WAO))
#define WPQ ((bf16*)(WSP + WS_WPQ))
#define EXPB ((bf16*)(WSP + WS_EXP))
#define HB ((bf16*)(WSP + WS_HB))
#define BIG0 ((bf16*)(WSP + WS_BIG))
#define BIG1 ((bf16*)(WSP + WS_BIG + 64 * MiB))
#define BIG2 ((bf16*)(WSP + WS_BIG + 128 * MiB))
#define IDX ((unsigned*)(WSP + WS_IDX))
#define GATE ((float*)(WSP + WS_GATE))

    { PHASE_IDS
        LAS float* scr = (LAS float*)(ldsl + RING_OFF + wave * 16384);
        constexpr int I_CI = 16 * 64, I_CO = 16 * 32, I_AI = 16 * 96, I_AO = 16 * 32, I_PQ = 16 * 64;
        constexpr int NIT = I_CI + I_CO + I_AI + I_AO + 2 * I_PQ;
        for (int it = gw; it < NIT; it += NGW) {
            int r = it;
            if (r < I_CI) { const int kb = r / 64, nb = r % 64, n0 = 32 * nb;
                const int dst = (n0 < 1024) ? (n0 / 128) * 256 + (n0 % 128) : ((n0 - 1024) / 128) * 256 + 128 + ((n0 - 1024) % 128);
                transpose_item(conv_in_w, 1024, 2048, WCI, 64 * kb, n0, dst, scr, lane); continue; } r -= I_CI;
            if (r < I_CO) { const int kb = r / 32, nb = r % 32; transpose_item(conv_out_w, 1024, 1024, WCO, 64 * kb, 32 * nb, 32 * nb, scr, lane); continue; } r -= I_CO;
            if (r < I_AI) { const int kb = r / 96, nb = r % 96; transpose_item(attn_in_w, 1024, NAI, WAI, 64 * kb, 32 * nb, 32 * nb, scr, lane); continue; } r -= I_AI;
            if (r < I_AO) { const int kb = r / 32, nb = r % 32; transpose_item(attn_out_w, 1024, 1024, WAO, 64 * kb, 32 * nb, 32 * nb, scr, lane); continue; } r -= I_AO;
            { const int l = r / I_PQ; r -= l * I_PQ; const int kb = r / 64, nb = r % 64;
              transpose_item(peer_query_w + (size_t)l * 1024 * 2048, 1024, 2048, WPQ + (size_t)l * 2048 * 1024, 64 * kb, 32 * nb, 32 * nb, scr, lane); }
        }
        const int gt = vcu * NTHR + tid, NGT = G * NTHR;
        for (int e = gt; e < 256 * 1024; e += NGT) { const int r = e >> 10, k = e & 1023;
            WAI[(size_t)(3072 + r) * 1024 + k] = (r < 16) ? (bf16)f2bf(attn_in_w[(size_t)k * NAI + 3072 + r]) : (bf16)0; }
        for (int e = gt; e < 2 * 2 * 16384; e += NGT) { const int l = e >> 15, hf = (e >> 14) & 1, i = e & 16383;
            SKB[e] = (bf16)f2bf((hf ? peer_sk2 : peer_sk1)[(size_t)l * 16384 + i]); }
        { constexpr size_t TBL = (size_t)NEXP * D;
          for (size_t e8 = gt; e8 < 4 * TBL / 8; e8 += NGT) { const size_t t = e8 / (TBL / 8), o = (e8 % (TBL / 8)) * 8;
              const float* src = ((t & 1) ? peer_v : peer_u) + (t >> 1) * TBL + o;
              const f32x4 a = *(const f32x4*)src, b = *(const f32x4*)(src + 4);
              v4u w; w.x = pk2(a[0], a[1]); w.y = pk2(a[2], a[3]); w.z = pk2(b[0], b[1]); w.w = pk2(b[2], b[3]);
              *(v4u*)(EXPB + t * TBL + o) = w; } }
        for (int it = bx; it < 4 * 6 * 16; it += G) { const int s = it / 96, rem = it % 96, jb = rem / 16, ksp = rem % 16; const int j = jb * 512 + tid;
            const float* W = ((s & 1) ? ada_ffn_w : ada_mix_w) + (size_t)(s >> 1) * 1024 * 3072; const float* bs = ((s & 1) ? ada_ffn_b : ada_mix_b) + (s >> 1) * 3072;
            float a[8];
#pragma unroll
            for (int b = 0; b < 8; ++b) a[b] = 0.f;
            for (int k = ksp * 64; k < ksp * 64 + 64; ++k) { const float w = W[(size_t)k * 3072 + j];
#pragma unroll
                for (int b = 0; b < 8; ++b) { const float cv = c_in[b * 1024 + k]; a[b] += (cv / (1.f + __expf(-cv))) * w; } }
            const float bj = (ksp == 0) ? bs[j] : 0.f;
#pragma unroll
            for (int b = 0; b < 8; ++b) atomicAdd(MOD + ((size_t)s * 8 + b) * 3072 + j, a[b] + bj); }
    }
    GRID_BAR();
    { PHASE_IDS
    for (int r = 0; r < 16; ++r) { const int m = gw * 16 + r; const float* mod = MOD + (size_t)(0 * 8 + (m >> 12)) * 3072;
        float x[16], g[16]; load16f(x_in + (size_t)m * D, lane, x); load16f(mod + 1024, lane, g);
#pragma unroll
        for (int i = 0; i < 16; ++i) x[i] *= (1.f + g[i]);
        load16f(mod, lane, g);
#pragma unroll
        for (int i = 0; i < 16; ++i) x[i] += g[i];
        store16bf(HB + (size_t)m * D, lane, x); } }
    GRID_BAR();

    if (PHM & 1) { pg8::Gemm g{HB, WCI, M, 2048, D}; pg8::StaticOrder S; S.init(M, 2048, G, bx);
      pg8::EpiGlu E{BIG0, conv_in_b};
      pg8::gemm_phase<pg8::EpiGlu, pg8::StaticOrder, PG8_ALIGN, PG8_SP2>(ldsl + RING_OFF, g, S, E); }
    GRID_BAR();
    if (PHM & 2) { PHASE_IDS
        constexpr int TT = 16;
        float* red = (float*)(lds + RING_OFF);
        float* stats = red + 8 * 2 * TT;
        const int c = 2 * tid;
        const float bd0 = conv_dw_b[c], bd1 = conv_dw_b[c + 1], lg0 = conv_ln_g[c], lg1 = conv_ln_g[c + 1], lb0 = conv_ln_b[c], lb1 = conv_ln_b[c + 1];
        const float* wdw = conv_dw_w + c;
        for (int tile = vcu; tile < M / TT; tile += G) {
            const int t0 = tile * TT, pos0 = t0 & (SEQ - 1);
            unsigned in[TT + 30];
#pragma unroll
            for (int j = 0; j < TT + 30; ++j) in[j] = (pos0 + j >= 30) ? *(const unsigned*)(BIG0 + (size_t)(t0 - 30 + j) * D + c) : 0u;
            float o0[TT], o1[TT];
#pragma unroll
            for (int i = 0; i < TT; ++i) { o0[i] = bd0; o1[i] = bd1; }
#pragma unroll
            for (int w = 0; w < 31; ++w) { const float w0 = wdw[w * D], w1 = wdw[w * D + 1];
#pragma unroll
                for (int i = 0; i < TT; ++i) { o0[i] += bf_lo(in[i + w]) * w0; o1[i] += bf_hi(in[i + w]) * w1; } }
#pragma unroll
            for (int i = 0; i < TT; ++i) { const float s = wave_sum(o0[i] + o1[i]), q = wave_sum(o0[i] * o0[i] + o1[i] * o1[i]);
                if (lane == 0) { red[(wave * TT + i) * 2] = s; red[(wave * TT + i) * 2 + 1] = q; } }
            __syncthreads();
            if (tid < 2 * TT) { float a = 0.f;
#pragma unroll
                for (int w = 0; w < 8; ++w) a += red[w * 2 * TT + tid];
                stats[tid] = a; }
            __syncthreads();
#pragma unroll
            for (int i = 0; i < TT; ++i) { const float mean = stats[2 * i] * (1.f / D); const float var = fmaxf(stats[2 * i + 1] * (1.f / D) - mean * mean, 0.f);
                const float rstd = 1.f / sqrtf(var + LN_EPS);
                float y0 = (o0[i] - mean) * rstd * lg0 + lb0, y1 = (o1[i] - mean) * rstd * lg1 + lb1;
                y0 = y0 / (1.f + __expf(-y0)); y1 = y1 / (1.f + __expf(-y1));
                *(unsigned*)(BIG1 + (size_t)(t0 + i) * D + c) = pk2(y0, y1); }
            __syncthreads();
        }
    }
    GRID_BAR();
    { pg8::Gemm g{BIG1, WCO, M, D, D}; pg8::StaticOrder S; S.init(M, D, G, bx);
      pg8::EpiBf16<0> E{BIG2, D, conv_out_b, 0, 0, 1.f};
      pg8::gemm_phase<pg8::EpiBf16<0>, pg8::StaticOrder, PG8_ALIGN, PG8_SP2>(ldsl + RING_OFF, g, S, E); }
    GRID_BAR();

    for (int layer = 0; layer < 2; ++layer) {
        if (layer == 1) {
            { pg8::Gemm g{HB, WAI, M, NAI_PAD, D}; pg8::StaticOrder S; S.init(M, NAI_PAD, G, bx);
              pg8::EpiQkvf E{pg8::EpiBf16<0>{BIG0, D, attn_in_b, D, (size_t)(64 * MiB) / 2, attn_body::C2}, LOGF, attn_in_b};
              pg8::gemm_phase<pg8::EpiQkvf, pg8::StaticOrder, PG8_ALIGN, PG8_SP2>(ldsl + RING_OFF, g, S, E); }
            GRID_BAR();
            if (PHM & 4) { PHASE_IDS
                float* kb = (float*)(lds + KB_OFF); float* wsum = (float*)(lds + KB_OFF + 16384);
                const int bh = vcu >> 1;
                const float* lf = LOGF + (size_t)bh * SEQ + 8 * tid;
                const f32x4 a = *(const f32x4*)lf, b = *(const f32x4*)(lf + 4);
                float p[8]; p[0] = a[0]; p[1] = p[0] + a[1]; p[2] = p[1] + a[2]; p[3] = p[2] + a[3]; p[4] = p[3] + b[0]; p[5] = p[4] + b[1]; p[6] = p[5] + b[2]; p[7] = p[6] + b[3];
                float incl = p[7];
#pragma unroll
                for (int o = 1; o < 64; o <<= 1) { const float t = __shfl_up(incl, o); if (lane >= o) incl += t; }
                if (lane == 63) wsum[wave] = incl;
                __syncthreads();
                float base = incl - p[7];
                for (int w = 0; w < wave; ++w) base += wsum[w];
#pragma unroll
                for (int i = 0; i < 8; ++i) kb[8 * tid + i] = -(base + p[i]) * 1.4426950408889634f;
                __syncthreads();
                const attn_body::AttnTensors AT{(const attn_body::bf16*)BIG0, (const attn_body::bf16*)BIG1, (const attn_body::bf16*)BIG2, (attn_body::bf16*)BIG0};
                const attn_body::StaticOrder S(G, bx);
                attn_body::attn_phase<attn_body::StaticOrder>((char*)lds + RING_OFF, AT, S, (attn_body::lds_fptr)(ldsl + KB_OFF));
            }
            GRID_BAR();
            { pg8::Gemm g{BIG0, WAO, M, D, D}; pg8::StaticOrder S; S.init(M, D, G, bx);
              pg8::EpiBf16<0> E{BIG1, D, attn_out_b, 0, 0, 1.f};
              pg8::gemm_phase<pg8::EpiBf16<0>, pg8::StaticOrder, PG8_ALIGN, PG8_SP2>(ldsl + RING_OFF, g, S, E); }
            GRID_BAR();
        }
        { PHASE_IDS
            const bf16* Y = (layer == 0) ? BIG2 : BIG1; const float* xin = (layer == 0) ? x_in : X;
            const int smix = 2 * layer, sffn = 2 * layer + 1;
            for (int r = 0; r < 16; ++r) { const int m = gw * 16 + r; const int b = m >> 12;
                const v4u y0 = *(const v4u*)(Y + (size_t)m * D + 8 * lane), y1 = *(const v4u*)(Y + (size_t)m * D + 512 + 8 * lane);
                float y[16];
                y[0] = bf_lo(y0.x); y[1] = bf_hi(y0.x); y[2] = bf_lo(y0.y); y[3] = bf_hi(y0.y); y[4] = bf_lo(y0.z); y[5] = bf_hi(y0.z); y[6] = bf_lo(y0.w); y[7] = bf_hi(y0.w);
                y[8] = bf_lo(y1.x); y[9] = bf_hi(y1.x); y[10] = bf_lo(y1.y); y[11] = bf_hi(y1.y); y[12] = bf_lo(y1.z); y[13] = bf_hi(y1.z); y[14] = bf_lo(y1.w); y[15] = bf_hi(y1.w);
                resid_ln_row(xin + (size_t)m * D, y, MOD + (size_t)(smix * 8 + b) * 3072 + 2048, ln_mix_g + layer * D, ln_mix_b + layer * D,
                             X + (size_t)m * D, HB + (size_t)m * D, MOD + (size_t)(sffn * 8 + b) * 3072, lane); }
        }
        GRID_BAR();
        { pg8::Gemm g{HB, WPQ + (size_t)layer * 2048 * 1024, M, 2048, D}; pg8::StaticOrder S; S.init(M, 2048, G, bx);
          pg8::EpiBf16<0> E{BIG0, 2048, nullptr, 0, 0, 1.f};
          pg8::gemm_phase<pg8::EpiBf16<0>, pg8::StaticOrder, PG8_ALIGN, PG8_SP2>(ldsl + RING_OFF, g, S, E); }
        GRID_BAR();
        if (PHM & 8) { PHASE_IDS for (int it = gw; it < (M / 32) * 8; it += NGW) peer_topk_item(BIG0, SKB + (size_t)layer * 2 * 16384, IDX, GATE, it >> 3, it & 7, lane); }
        GRID_BAR();
        if (PHM & 16) { PHASE_IDS
            const bf16* U = EXPB + (size_t)(2 * layer) * NEXP * D; const bf16* V = EXPB + (size_t)(2 * layer + 1) * NEXP * D;
            const int sffn = 2 * layer + 1;
            for (int r = 0; r < 16; ++r) { const int m = gw * 16 + r; const int b = m >> 12;
                float y[16];
                peer_gather_token(HB + (size_t)m * D, IDX + (size_t)m * NSEL, GATE + (size_t)m * NSEL, U, V, lane, y);
                resid_ln_row(X + (size_t)m * D, y, MOD + (size_t)(sffn * 8 + b) * 3072 + 2048, ln_ffn_g + layer * D, ln_ffn_b + layer * D,
                             X + (size_t)m * D, HB + (size_t)m * D, (layer == 0) ? MOD + (size_t)(2 * 8 + b) * 3072 : nullptr, lane); }
        }
        if (layer == 0) GRID_BAR();
    }
}

extern "C" void kernel_launch(void* const* d_in, const int* in_sizes, int n_in, void* d_out, int out_size, void* d_ws, size_t ws_size, hipStream_t stream) {
    static int grid = 0;
    if (grid == 0) {
        if (n_in != 27 || in_sizes[0] != M * D || out_size != M * D || ws_size < WS_END) { fprintf(stderr, "kernel_launch: unexpected shapes (n_in %d, in0 %d, out %d, ws %zu); nothing launched\n", n_in, n_in > 0 ? in_sizes[0] : -1, out_size, ws_size); grid = -1; return; }
        int dev = 0, cus = 0, per_cu = 0;
        if (hipGetDevice(&dev) != hipSuccess || hipDeviceGetAttribute(&cus, hipDeviceAttributeMultiprocessorCount, dev) != hipSuccess) { grid = -1; return; }
        if (hipFuncSetAttribute((const void*)trunk_fwd, hipFuncAttributeMaxDynamicSharedMemorySize, LDS_BYTES) != hipSuccess) { fprintf(stderr, "kernel_launch: hipFuncSetAttribute failed\n"); grid = -1; return; }
        if (hipOccupancyMaxActiveBlocksPerMultiprocessor(&per_cu, (const void*)trunk_fwd, NTHR, LDS_BYTES) != hipSuccess || per_cu < 1) { fprintf(stderr, "kernel_launch: occupancy query reports %d blocks per CU\n", per_cu); }
        (void)hipGetLastError();
        grid = cus;
        if (grid != 256) fprintf(stderr, "kernel_launch: %d CUs; this build expects 256\n", grid);
    }
    if (grid < 0) return;
    if (hipMemsetAsync((char*)d_ws + WS_CTL, 0, CTL_ZERO_BYTES, stream) != hipSuccess) return;
    Args a{};
    for (int i = 0; i < 27; ++i) a.in[i] = (const float*)d_in[i];
    a.out = (float*)d_out; a.ws = (unsigned char*)d_ws;
    hipLaunchKernelGGL(trunk_fwd, dim3(grid), dim3(NTHR), LDS_BYTES, stream, a);
}
```

```cpp
#include <hip/hip_runtime.h>
#include <cstdio>
#include <cstdint>
namespace pg8 {
#define PG8_LAS __attribute__((address_space(3)))
typedef unsigned short bf16_t;
typedef short bf16x8 __attribute__((ext_vector_type(8)));
typedef float f32x4 __attribute__((ext_vector_type(4)));
typedef unsigned u32x4 __attribute__((ext_vector_type(4)));
constexpr int BM = 256, BK = 64, HALF = 128, HTB = HALF * BK * 2  , STAGE_BYTES = 8 * HTB, NXCD = 8, WGM = 8;

__host__ __device__ __forceinline__ int lds_byte(int r, int c) { const int st = (r >> 4) * 2 + (c >> 5), rr = r & 15, cc = c & 31, ob = rr * 64 + cc * 2; return st * 1024 + (ob ^ (((ob >> 9) & 1) << 5)); }
__host__ __device__ __forceinline__ void stage_rc(int b, int& R, int& C) { const int st = b / 1024, sb = b % 1024, swz = sb ^ (((sb >> 9) & 1) << 5); R = (st >> 1) * 16 + swz / 64; C = (st & 1) * 32 + (swz % 64) / 2; }
__host__ __device__ __forceinline__ int perm32(int rho) { const int n = rho >> 4, i = rho & 15; return 8 * (i >> 2) + 4 * n + (i & 3); }

struct Unit { int pm, pn; };
struct Gemm { const bf16_t* A; const bf16_t* Bt; int M, N, K; };

struct StaticOrder {
    int nM, nN, nwg, G, c;
    __host__ __device__ void init(int M, int N, int G_, int c_) { nM = M / BM; nN = N / BM; nwg = nM * nN; G = G_; c = c_; }
    __host__ __device__ bool next(int i, Unit& u) const {
        const long L = (long)i * G + c; if (L >= nwg) return false;
        int wgid = (int)L; { const int q = nwg / NXCD, r = nwg % NXCD, xcd = wgid % NXCD, off = wgid / NXCD; wgid = (xcd < r ? xcd * (q + 1) : r * (q + 1) + (xcd - r) * q) + off; }
        const int nig = WGM * nN, gid = wgid / nig, fm = gid * WGM, gsz = (nM - fm) < WGM ? (nM - fm) : WGM;
        u.pm = fm + ((wgid % nig) % gsz); u.pn = (wgid % nig) / gsz; return true;
    }
    __device__ __forceinline__ void a_ready(const Unit&) const {}
    __device__ __forceinline__ void done(const Unit&) const {}
};

__device__ __forceinline__ unsigned cvt_pk_bf16(float lo, float hi) { unsigned r; asm volatile("v_cvt_pk_bf16_f32 %0, %1, %2" : "=v"(r) : "v"(lo), "v"(hi)); return r; }
typedef float f32x2 __attribute__((ext_vector_type(2)));
__device__ __forceinline__ f32x2 gelu_pk(f32x2 v) {
    const f32x2 av = __builtin_elementwise_abs(v), d = av * 0.2316418882f + 1.0f;
    f32x2 t; t.x = __builtin_amdgcn_rcpf(d.x); t.y = __builtin_amdgcn_rcpf(d.y);
    f32x2 q = t * 0.5307027145f + (-0.7265760135f); q = q * t + 0.7107068705f; q = q * t + (-0.142248368f); q = q * t + 0.127414796f; q = q * t;
    const f32x2 s = (v * v) * (-0.72134752044f);
    f32x2 e; e.x = __builtin_amdgcn_exp2f(s.x); e.y = __builtin_amdgcn_exp2f(s.y);
    const f32x2 m = v * (q * e), r = v - m;
    f32x2 o; o.x = v.x < 0.f ? m.x : r.x; o.y = v.y < 0.f ? m.y : r.y; return o;
}

template <int ACT  > struct EpiBf16 {
    static constexpr bool PERM = true, AFTER_DRAIN = false; static_assert(ACT == 0 || ACT == 1, "EpiBf16: ACT is 0 (none) or 1 (gelu_pk)");
    bf16_t* O; int ldc; const float* bias; int split_cols; size_t split_stride; float scale0;
    __device__ __forceinline__ void operator()(const f32x4 (&acc)[2][2][4][2], const Unit& u, int wr, int wc, int fr, int fq) const {
        const int row0 = u.pm * BM + wr * 64 + fr; int colt = u.pn * BM; bf16_t* base = O;
        float sc = 1.f; if (split_cols) { const int t = colt / split_cols; base += (size_t)t * split_stride; colt -= t * split_cols; if (t == 0) sc = scale0; }
        const int col0 = colt + wc * 32 + 8 * fq, bcol0 = u.pn * BM + wc * 32 + 8 * fq;
        f32x4 bv[2][2];
#pragma unroll
        for (int bj = 0; bj < 2; ++bj)
#pragma unroll
            for (int n = 0; n < 2; ++n) bv[bj][n] = bias ? *(const f32x4*)(bias + bcol0 + bj * HALF + 4 * n) : (f32x4){0.f, 0.f, 0.f, 0.f};
#pragma unroll
        for (int ai = 0; ai < 2; ++ai)
#pragma unroll
            for (int m = 0; m < 4; ++m) { bf16_t* rowp = base + (size_t)(row0 + ai * HALF + m * 16) * ldc + col0;
#pragma unroll
                for (int bj = 0; bj < 2; ++bj) { f32x4 v0 = acc[ai][bj][m][0] + bv[bj][0], v1 = acc[ai][bj][m][1] + bv[bj][1];
                    if (ACT == 1) { f32x2 a = gelu_pk((f32x2){v0[0], v0[1]}), b = gelu_pk((f32x2){v0[2], v0[3]}), c = gelu_pk((f32x2){v1[0], v1[1]}), d = gelu_pk((f32x2){v1[2], v1[3]});
                        v0 = (f32x4){a.x, a.y, b.x, b.y}; v1 = (f32x4){c.x, c.y, d.x, d.y}; }
                    v0 = v0 * sc; v1 = v1 * sc; u32x4 w; w.x = cvt_pk_bf16(v0[0], v0[1]); w.y = cvt_pk_bf16(v0[2], v0[3]); w.z = cvt_pk_bf16(v1[0], v1[1]); w.w = cvt_pk_bf16(v1[2], v1[3]);
                    *(u32x4*)(rowp + bj * HALF) = w; } }
    }
};
template <bool I8> __device__ __forceinline__ f32x4 mma16(const bf16x8 a, const bf16x8 b, const f32x4 c) {
    if constexpr (I8) { typedef int v4i_t __attribute__((ext_vector_type(4)));
        return __builtin_bit_cast(f32x4, __builtin_amdgcn_mfma_i32_16x16x64_i8(__builtin_bit_cast(v4i_t, a), __builtin_bit_cast(v4i_t, b), __builtin_bit_cast(v4i_t, c), 0, 0, 0)); }
    else return __builtin_amdgcn_mfma_f32_16x16x32_bf16(a, b, c, 0, 0, 0);
}
template <class Epi, class Sched, bool ALIGN_EPI = false, bool SP2 = false, bool I8 = false>
__device__ __forceinline__ void gemm_phase(PG8_LAS unsigned char* lds, const Gemm g, const Sched& S, const Epi& E) {
    int tid = threadIdx.x; asm volatile("" : "+v"(tid)); const int wid = __builtin_amdgcn_readfirstlane(tid >> 6), lane = tid & 63, wr = wid >> 2, wc = wid & 3, fr = lane & 15, fq = lane >> 4;
    const int K = g.K, nt = K / BK;
    unsigned voffA[2], voffB[2];
#pragma unroll
    for (int i = 0; i < 2; ++i) { int R, C; stage_rc(tid * 16 + i * 8192, R, C); const int Rb = Epi::PERM ? ((R & ~31) + perm32(R & 31)) : R;
        voffA[i] = (unsigned)(R * K + C) * 2u; voffB[i] = (unsigned)(Rb * K + C) * 2u; }
    const size_t kstep = (size_t)(BK * 2);
    const size_t hstep = (size_t)HALF * K * 2;
    const size_t tstep = 2 * hstep;
    const unsigned ldsw = (unsigned)wid * 1024u;
    const int aoff = lds_byte(wr * 64 + fr, fq * 8), boff = lds_byte(wc * 32 + fr, fq * 8);
#define PG8_SA(b, h) (((b) * 2 + (h)) * HTB)
#define PG8_SB(b, h) ((4 + (b) * 2 + (h)) * HTB)
#define PG8_STAGE(bufoff, gbase, voff) do { _Pragma("unroll") for (int _i = 0; _i < 2; ++_i) \
        __builtin_amdgcn_global_load_lds((const unsigned*)((const char*)(gbase) + (voff)[_i]), (PG8_LAS unsigned*)(lds + (bufoff) + ldsw + _i * 8192), 16, 0, 0); } while (0)
#define PG8_LDA(dst, b, h) do { _Pragma("unroll") for (int m = 0; m < 4; ++m) _Pragma("unroll") for (int k = 0; k < 2; ++k) dst[m][k] = *(const PG8_LAS bf16x8*)(lds + PG8_SA(b, h) + aoff + m * 2048 + k * 1024); } while (0)
#define PG8_LDB(dst, b, h) do { _Pragma("unroll") for (int n = 0; n < 2; ++n) _Pragma("unroll") for (int k = 0; k < 2; ++k) dst[n][k] = *(const PG8_LAS bf16x8*)(lds + PG8_SB(b, h) + boff + n * 2048 + k * 1024); } while (0)
#define PG8_MMA(ai, bj, At, Bt) do { __builtin_amdgcn_s_setprio(1); _Pragma("unroll") for (int m = 0; m < 4; ++m) _Pragma("unroll") for (int n = 0; n < 2; ++n) _Pragma("unroll") for (int k = 0; k < 2; ++k) \
        acc[ai][bj][m][n] = mma16<I8>(Bt[n][k], At[m][k], acc[ai][bj][m][n]); __builtin_amdgcn_s_setprio(0); } while (0)
#define PG8_WAIT_V(n) asm volatile("s_waitcnt vmcnt(" #n ")" ::: "memory")
#define PG8_WAIT_L(n) asm volatile("s_waitcnt lgkmcnt(" #n ")" ::: "memory")
#define PG8_BAR __builtin_amdgcn_s_barrier()
#define PG8_SCHED __builtin_amdgcn_sched_barrier(0)
    Unit cur, nxt; int ui = 0;
    if (!S.next(0, cur)) return;
    f32x4 acc[2][2][4][2];
#pragma unroll
    for (int a = 0; a < 2; ++a)
#pragma unroll
        for (int b = 0; b < 2; ++b)
#pragma unroll
            for (int m = 0; m < 4; ++m)
#pragma unroll
                for (int n = 0; n < 2; ++n) acc[a][b][m][n] = (f32x4){0.f, 0.f, 0.f, 0.f};
    bf16x8 At[4][2], B0[2][2], B1[2][2];
    const char* cA = (const char*)g.A + (size_t)cur.pm * tstep; const char* cB = (const char*)g.Bt + (size_t)cur.pn * tstep;
    S.a_ready(cur);
    if constexpr (SP2) {
        PG8_STAGE(PG8_SB(0, 0), cB, voffB); PG8_STAGE(PG8_SB(0, 1), cB + hstep, voffB); PG8_STAGE(PG8_SA(0, 0), cA, voffA); PG8_STAGE(PG8_SA(0, 1), cA + hstep, voffA);
        if (wr == 1) PG8_BAR;
        PG8_WAIT_V(2); PG8_BAR;
        PG8_STAGE(PG8_SB(1, 0), cB + kstep, voffB); PG8_STAGE(PG8_SA(1, 0), cA + kstep, voffA); PG8_STAGE(PG8_SB(1, 1), cB + hstep + kstep, voffB);
        PG8_WAIT_V(6); PG8_BAR;
    } else {
        PG8_STAGE(PG8_SB(0, 0), cB, voffB); PG8_STAGE(PG8_SA(0, 0), cA, voffA); PG8_STAGE(PG8_SB(0, 1), cB + hstep, voffB); PG8_STAGE(PG8_SA(0, 1), cA + hstep, voffA);
        if (wr == 1) PG8_BAR;
        PG8_WAIT_V(4); PG8_BAR;
        PG8_STAGE(PG8_SB(1, 0), cB + kstep, voffB); PG8_STAGE(PG8_SA(1, 0), cA + kstep, voffA); PG8_STAGE(PG8_SB(1, 1), cB + hstep + kstep, voffB);
        PG8_WAIT_V(6); PG8_BAR;
    }
    for (;;) {
        const bool has_next = S.next(ui + 1, nxt);
        const char* nA = has_next ? (const char*)g.A + (size_t)nxt.pm * tstep : cA; const char* nB = has_next ? (const char*)g.Bt + (size_t)nxt.pn * tstep : cB;
        for (int t = 0; t < nt; t += 2) {
            const bool last = (t == nt - 2);
            const char* a1 = cA + (size_t)(t + 1) * kstep;
            const char* a2 = last ? nA : cA + (size_t)(t + 2) * kstep; const char* b2 = last ? nB : cB + (size_t)(t + 2) * kstep;
            const char* a3 = a2 + kstep; const char* b3 = b2 + kstep;
            if (last && has_next) S.a_ready(nxt);
            if constexpr (SP2) {
            PG8_LDB(B0, 0, 0); PG8_LDB(B1, 0, 1); PG8_SCHED; PG8_LDA(At, 0, 0); PG8_STAGE(PG8_SA(1, 1), a1 + hstep, voffA);
            PG8_WAIT_V(8); PG8_WAIT_L(0); PG8_BAR; PG8_MMA(0, 0, At, B0); PG8_MMA(0, 1, At, B1); PG8_BAR; PG8_SCHED;
            PG8_LDA(At, 0, 1); PG8_STAGE(PG8_SB(0, 0), b2, voffB); PG8_STAGE(PG8_SB(0, 1), b2 + hstep, voffB); PG8_STAGE(PG8_SA(0, 0), a2, voffA);
            PG8_WAIT_V(8); PG8_WAIT_L(0); PG8_BAR; PG8_MMA(1, 0, At, B0); PG8_MMA(1, 1, At, B1); PG8_BAR; PG8_SCHED;
            PG8_LDB(B0, 1, 0); PG8_LDB(B1, 1, 1); PG8_SCHED; PG8_LDA(At, 1, 0); PG8_STAGE(PG8_SA(0, 1), a2 + hstep, voffA);
            PG8_WAIT_V(8); PG8_WAIT_L(0); PG8_BAR; PG8_MMA(0, 0, At, B0); PG8_MMA(0, 1, At, B1); PG8_BAR; PG8_SCHED;
            PG8_LDA(At, 1, 1); PG8_STAGE(PG8_SB(1, 0), b3, voffB); PG8_STAGE(PG8_SB(1, 1), b3 + hstep, voffB); PG8_STAGE(PG8_SA(1, 0), a3, voffA);
            PG8_WAIT_V(8); PG8_WAIT_L(0); PG8_BAR; PG8_MMA(1, 0, At, B0); PG8_MMA(1, 1, At, B1); PG8_BAR; PG8_SCHED;
            } else {
            PG8_LDB(B0, 0, 0); PG8_SCHED; PG8_LDA(At, 0, 0); PG8_STAGE(PG8_SA(1, 1), a1 + hstep, voffA);
            PG8_WAIT_L(8); PG8_BAR; PG8_WAIT_L(0); PG8_MMA(0, 0, At, B0); PG8_BAR; PG8_SCHED;
            PG8_LDB(B1, 0, 1); PG8_STAGE(PG8_SB(0, 0), b2, voffB);
            PG8_BAR; PG8_WAIT_L(0); PG8_MMA(0, 1, At, B1); PG8_BAR;
            PG8_LDA(At, 0, 1); PG8_STAGE(PG8_SA(0, 0), a2, voffA);
            PG8_BAR; PG8_WAIT_L(0); PG8_MMA(1, 0, At, B0); PG8_BAR; PG8_SCHED;
            PG8_STAGE(PG8_SB(0, 1), b2 + hstep, voffB);
            PG8_WAIT_V(6); PG8_BAR; PG8_MMA(1, 1, At, B1); PG8_BAR;
            PG8_LDB(B0, 1, 0); PG8_SCHED; PG8_LDA(At, 1, 0); PG8_STAGE(PG8_SA(0, 1), a2 + hstep, voffA);
            PG8_WAIT_L(8); PG8_BAR; PG8_WAIT_L(0); PG8_MMA(0, 0, At, B0); PG8_BAR; PG8_SCHED;
            PG8_LDB(B1, 1, 1); PG8_STAGE(PG8_SB(1, 0), b3, voffB);
            PG8_BAR; PG8_WAIT_L(0); PG8_MMA(0, 1, At, B1); PG8_BAR;
            PG8_LDA(At, 1, 1); PG8_STAGE(PG8_SA(1, 0), a3, voffA);
            PG8_BAR; PG8_WAIT_L(0); PG8_MMA(1, 0, At, B0); PG8_BAR; PG8_SCHED;
            PG8_STAGE(PG8_SB(1, 1), b3 + hstep, voffB);
            PG8_WAIT_V(6); PG8_BAR; PG8_MMA(1, 1, At, B1); PG8_BAR;
            }
        }
        if constexpr (ALIGN_EPI) { if (wr == 0) PG8_BAR; }
        if constexpr (!Epi::AFTER_DRAIN) { E(acc, cur, wr, wc, fr, fq); S.done(cur); }
        if (!has_next) break;
#pragma unroll
        for (int a = 0; a < 2; ++a)
#pragma unroll
            for (int b = 0; b < 2; ++b)
#pragma unroll
                for (int m = 0; m < 4; ++m)
#pragma unroll
                    for (int n = 0; n < 2; ++n) acc[a][b][m][n] = (f32x4){0.f, 0.f, 0.f, 0.f};
        cur = nxt; cA = nA; cB = nB; ++ui;
        if constexpr (ALIGN_EPI) { if (wr == 1) PG8_BAR; }
    }
    PG8_WAIT_V(0);
    if constexpr (!ALIGN_EPI) { if (wr == 0) PG8_BAR; }
    PG8_BAR;
    if constexpr (Epi::AFTER_DRAIN) { E.fused(acc, cur, wr, wc, fr, fq, lds, wid, lane); S.done(cur); }
#undef PG8_SA
#undef PG8_SB
#undef PG8_STAGE
#undef PG8_LDA
#undef PG8_LDB
#undef PG8_MMA
#undef PG8_WAIT_V
#undef PG8_WAIT_L
#undef PG8_BAR
#undef PG8_SCHED
}
}

#ifndef PG8_SP2
#define PG8_SP2 true
#endif
#ifndef PG8_ALIGN
#define PG8_ALIGN true
#endif
#include <hip/hip_bf16.h>
#include <cmath>
namespace attn_body {
using bf16=__hip_bfloat16;
using bf16x8=__attribute__((ext_vector_type(8)))short;
using s16x4=__attribute__((ext_vector_type(4)))short;
using f32x16=__attribute__((ext_vector_type(16)))float;
using u32x4=__attribute__((ext_vector_type(4)))unsigned;
using f32x4_t=__attribute__((ext_vector_type(4)))float;
typedef __attribute__((address_space(3))) const float* lds_fptr;
constexpr int BATCH=8,NHEAD=16,SEQ=4096,D=64,DM=NHEAD*D;
constexpr int NW=8,QBLK=32,QB=QBLK*NW,KVBLK=64,NQB=SEQ/QB;
constexpr int ATTN_PITCH=DM, ATTN_UNIT_ROWS=QB;
__device__ __forceinline__ int crow(int r,int hi){return (r&3)+8*(r>>2)+4*hi;}
#define SBAR() __builtin_amdgcn_sched_barrier(0)
__device__ __forceinline__ void cmask(f32x16&p0,f32x16&p1,int jb,int qrel,int hi){
  const float NEG=-INFINITY; int kb=64*jb+4*hi;
  #pragma unroll
  for(int r=0;r<16;++r){int kv=kb+(r&3)+8*(r>>2); if(kv>qrel)p0[r]=NEG; if(kv+32>qrel)p1[r]=NEG;}
}

constexpr int NSLOT=3, SLOTB=8192;
constexpr int LDS_K=0, LDS_V=NSLOT*SLOTB, LDS_WS=2*NSLOT*SLOTB, LDS_OST=LDS_WS+NW*64*4, LDS_BYTES=LDS_OST+NW*4096;
constexpr float C2=0.125f*1.4426950408889634f;
__device__ __forceinline__ void glds16(const void*gsrc,unsigned lds_dst){unsigned keep;
  asm volatile("s_mov_b32 %0, m0\n\ts_mov_b32 m0, %2\n\ts_nop 0\n\tglobal_load_lds_dwordx4 %1, off\n\ts_mov_b32 m0, %0":"=&s"(keep):"v"(gsrc),"s"(lds_dst):"memory");}
__device__ __forceinline__ float max3f(float a,float b,float c){float r;asm("v_max3_f32 %0, %1, %2, %3":"=v"(r):"v"(a),"v"(b),"v"(c));return r;}
__device__ __forceinline__ float max2f(float a,float b){float r;asm("v_max_f32_e32 %0, %1, %2":"=v"(r):"v"(a),"v"(b));return r;}
__device__ __forceinline__ float fadd_s(float a,float b){float r;asm("v_add_f32_e32 %0, %1, %2":"=v"(r):"v"(a),"v"(b));return r;}
__device__ __forceinline__ float fsub_s(float a,float b){float r;asm("v_sub_f32_e32 %0, %1, %2":"=v"(r):"v"(a),"v"(b));return r;}
typedef float f32x2_t __attribute__((ext_vector_type(2))); typedef __bf16 bf16x2_t __attribute__((ext_vector_type(2)));
__device__ __forceinline__ unsigned cvtpk_s(float lo,float hi){f32x2_t v={lo,hi};bf16x2_t b=__builtin_convertvector(v,bf16x2_t);return __builtin_bit_cast(unsigned,b);}
#define WAIT_BAR(N) asm volatile("s_waitcnt vmcnt(" #N ") lgkmcnt(0)\n\ts_barrier":::"memory")

__device__ __forceinline__ void qkt(f32x16&p0,f32x16&p1,const char*Kslot,const bf16x8*qr,int r32,int hi){
  const char*kb=Kslot+hi*1024+r32*16;
  #pragma unroll
  for(int d0=0;d0<4;++d0){
    const bf16x8 b0=*reinterpret_cast<const bf16x8*>(kb+d0*2048);
    const bf16x8 b1=*reinterpret_cast<const bf16x8*>(kb+d0*2048+512);
    p0=__builtin_amdgcn_mfma_f32_32x32x16_bf16(b0,qr[d0],p0,0,0,0);p1=__builtin_amdgcn_mfma_f32_32x32x16_bf16(b1,qr[d0],p1,0,0,0);}
}
typedef __attribute__((address_space(3))) const char* lds_cptr;
typedef short v4i16_t __attribute__((ext_vector_type(4)));
__device__ __forceinline__ void kload8(bf16x8*kf,lds_cptr kp){
  kf[0]=*(const __attribute__((address_space(3))) bf16x8*)(kp);      kf[1]=*(const __attribute__((address_space(3))) bf16x8*)(kp+512);
  kf[2]=*(const __attribute__((address_space(3))) bf16x8*)(kp+2048); kf[3]=*(const __attribute__((address_space(3))) bf16x8*)(kp+2560);
  kf[4]=*(const __attribute__((address_space(3))) bf16x8*)(kp+4096); kf[5]=*(const __attribute__((address_space(3))) bf16x8*)(kp+4608);
  kf[6]=*(const __attribute__((address_space(3))) bf16x8*)(kp+6144); kf[7]=*(const __attribute__((address_space(3))) bf16x8*)(kp+6656);
}
__device__ __forceinline__ void kload2(bf16x8*kf,lds_cptr kp,int j){ kf[2*j]=*(const __attribute__((address_space(3))) bf16x8*)(kp+j*2048); kf[2*j+1]=*(const __attribute__((address_space(3))) bf16x8*)(kp+j*2048+512); }
__device__ __forceinline__ s16x4 vtr(lds_cptr p){ return __builtin_bit_cast(s16x4,__builtin_amdgcn_ds_read_tr16_b64_v4i16((__attribute__((address_space(3))) v4i16_t*)p)); }
__device__ __forceinline__ float rowmax(const f32x16&p0,const f32x16&p1){
  float a=max3f(p0[0],p0[1],p1[0]),b=max3f(p0[2],p0[3],p1[1]);a=max3f(a,p1[2],p1[3]);
  #pragma unroll
  for(int r=4;r<16;r+=4){a=max3f(a,p0[r],p0[r+1]);b=max3f(b,p0[r+2],p0[r+3]);a=max3f(a,p1[r],p1[r+1]);b=max3f(b,p1[r+2],p1[r+3]);}
  const float m=max2f(a,b);
  auto rr=__builtin_amdgcn_permlane32_swap(__float_as_uint(m),__float_as_uint(m),false,false);
  return max2f(__uint_as_float(rr[0]),__uint_as_float(rr[1]));
}
__device__ __forceinline__ void pv(f32x16*o,int vb,bf16x8 pa0,bf16x8 pa1,bf16x8 pa2,bf16x8 pa3){
  #pragma unroll
  for(int d0=0;d0<2;++d0){s16x4 lo[4],hi[4];
    #pragma unroll
    for(int ks=0;ks<4;++ks){
      asm volatile("ds_read_b64_tr_b16 %0,%1 offset:%c2":"=&v"(lo[ks]):"v"(vb),"i"(d0*4096+ks*1024):"memory");
      asm volatile("ds_read_b64_tr_b16 %0,%1 offset:%c2":"=&v"(hi[ks]):"v"(vb),"i"(d0*4096+ks*1024+512):"memory");}
    asm volatile("s_waitcnt lgkmcnt(0)":::"memory");SBAR();
    #define PK(k) (bf16x8){lo[k][0],lo[k][1],lo[k][2],lo[k][3],hi[k][0],hi[k][1],hi[k][2],hi[k][3]}
    o[d0]=__builtin_amdgcn_mfma_f32_32x32x16_bf16(pa0,PK(0),o[d0],0,0,0);
    o[d0]=__builtin_amdgcn_mfma_f32_32x32x16_bf16(pa1,PK(1),o[d0],0,0,0);
    o[d0]=__builtin_amdgcn_mfma_f32_32x32x16_bf16(pa2,PK(2),o[d0],0,0,0);
    o[d0]=__builtin_amdgcn_mfma_f32_32x32x16_bf16(pa3,PK(3),o[d0],0,0,0);
    #undef PK
  }
}

#ifndef ATTN_STORE16
#define ATTN_STORE16(p,v) (*(u32x4*)(p)=(v))
#endif
template<int THRL> __device__ __forceinline__ void attn_unit(int b,int h,int qb,const bf16*Q,const bf16*__restrict__ K,const bf16*__restrict__ V,bf16*O,char*shm,lds_fptr kbl){
  int tid=threadIdx.x; asm volatile("":"+v"(tid)); const int lane=tid&63,r32=lane&31,hi=lane>>5; const int wid=__builtin_amdgcn_readfirstlane(tid>>6);
  const long rowbase=(long)b*SEQ; const int q0=qb*QB;
  const bf16*Qw=Q+(rowbase+q0+wid*QBLK)*DM+h*D;
  const bf16*Kh=K+rowbase*DM+h*D,*Vh=V+rowbase*DM+h*D;
  const unsigned lds0=(unsigned)(uintptr_t)shm;
  float*wsf=(float*)(shm+LDS_WS)+wid*64;
  const bf16*ksrc=Kh+(long)lane*DM+wid*8;
  const bf16*vsrc=Vh+(long)(16*(wid&3)+(lane>>2))*DM+(wid>>2)*32+(lane&3)*8;
  const unsigned kdst=lds0+LDS_K+wid*1024, vdst=lds0+LDS_V+wid*1024;
  #define DMA_K(t,slot) glds16(ksrc+(long)(t)*KVBLK*DM,(unsigned)__builtin_amdgcn_readfirstlane(kdst+(slot)))
  #define DMA_V(t,slot) glds16(vsrc+(long)(t)*KVBLK*DM,(unsigned)__builtin_amdgcn_readfirstlane(vdst+(slot)))
  const int vb0=(int)(lds0+LDS_V)+((lane>>4)&1)*32+(lane&3)*8+(4*hi+((lane&15)>>2))*64;
  const char*Kbase=shm+LDS_K; bf16x8 kf[8];
  const lds_cptr shm3=(lds_cptr)shm; const lds_cptr kp0=shm3+LDS_K+hi*1024+r32*16; const lds_cptr vp0=shm3+LDS_V+((lane>>4)&1)*32+(lane&3)*8+(4*hi+((lane&15)>>2))*64;
  const int NT=(q0+QB)/KVBLK;
  DMA_K(0,0);DMA_V(0,0);DMA_K(1,SLOTB);
  bf16x8 qr[4];
  #pragma unroll
  for(int d0=0;d0<4;++d0)qr[d0]=*reinterpret_cast<const bf16x8*>(&Qw[(long)r32*DM+d0*16+hi*8]);
  float mhat=0.f,l_reg=0.f;f32x16 o[2];o[0]=f32x16{};o[1]=f32x16{};
  const lds_fptr kbh=kbl+4*hi;
  #define KBLOAD(X0,X1,t) do{ const lds_fptr kb_=kbh+(t)*64; _Pragma("unroll") for(int g_=0;g_<4;++g_){ const f32x4_t a_=*(const __attribute__((address_space(3))) f32x4_t*)(kb_+8*g_), b_=*(const __attribute__((address_space(3))) f32x4_t*)(kb_+32+8*g_); _Pragma("unroll") for(int i_=0;i_<4;++i_){X0[4*g_+i_]=a_[i_];X1[4*g_+i_]=b_[i_];} } }while(0)
  #define KBSUB(C0,C1) do{ _Pragma("unroll") for(int r_=0;r_<16;++r_){C0[r_]-=mhat;C1[r_]-=mhat;} }while(0)
  #define KBINIT(C0,C1,t) do{ KBLOAD(C0,C1,t); KBSUB(C0,C1); }while(0)
  const int qrel=wid*QBLK+r32;
  #define CMASK(P0,P1,t) do{int jb_=(t)-(NT-4); if(jb_>=0)cmask(P0,P1,jb_,qrel,hi);}while(0)
  bool resc=false;
  #define START(P0,P1) do{ const float rm=rowmax(P0,P1); resc=false; \
    { const float dl=rm; mhat=fadd_s(mhat,dl); \
      _Pragma("unroll") for(int r=0;r<16;++r){P0[r]=fsub_s(P0[r],dl);P1[r]=fsub_s(P1[r],dl);} } \
    _Pragma("unroll") for(int r=0;r<16;++r)P0[r]=__builtin_amdgcn_exp2f(P0[r]); }while(0)
  #define RESC() do{ if(resc){ asm volatile("s_waitcnt lgkmcnt(0)":::"memory"); \
      _Pragma("unroll") for(int d_=0;d_<2;++d_) _Pragma("unroll") for(int r=0;r<16;++r)o[d_][r]*=wsf[crow(r,hi)]; } }while(0)
  f32x16 pA0,pA1,pB0,pB1;
  int sl_prev=0,sl_cur=0,sl_next=SLOTB;
  #define ROT() do{sl_prev=sl_cur;sl_cur=sl_next;sl_next=(sl_next==(NSLOT-1)*SLOTB)?0:sl_next+SLOTB;}while(0)
  DMA_K(2,2*SLOTB);
  WAIT_BAR(3);
  KBINIT(pA0,pA1,0); qkt(pA0,pA1,Kbase,qr,r32,hi);asm volatile("s_nop 15\n\ts_nop 7":"+v"(pA0),"+v"(pA1));CMASK(pA0,pA1,0);
  START(pA0,pA1);
  _Pragma("unroll") for(int r=0;r<16;++r)pA1[r]=__builtin_amdgcn_exp2f(pA1[r]);
  WAIT_BAR(0);
  DMA_K(3,0);DMA_V(1,SLOTB);
  ROT();
  kload8(kf,kp0+sl_cur);
  WAIT_BAR(2);
  s16x4 vlo[8],vhi[8]; u32x4 pw0,pw1,pw2,pw3;
  #define PKW(P,B) cvtpk_s(P[B],P[B+1])
  #define PAF(k) __builtin_bit_cast(bf16x8,pw##k)
  #define VFR(i) (bf16x8){vlo[i][0],vlo[i][1],vlo[i][2],vlo[i][3],vhi[i][0],vhi[i][1],vhi[i][2],vhi[i][3]}
  #define PIN(x) asm volatile("":"+v"(x))
  #define MX3(a,b,c) __builtin_fmaxf(__builtin_fmaxf((a),(b)),(c))
  #define GAPA(MF,A0,A1,A2,A3,W0,W1,PW) do{ MF; sacc+=A0; sacc+=A1; sacc+=A2; sacc+=A3; PIN(sacc); W0; W1; PIN(PW); SBAR(); }while(0)
  #define EX(v) __builtin_amdgcn_exp2f(v)
  #define GAPB(MF,X,B) do{ MF; X[B]=EX(X[B]); X[B+1]=EX(X[B+1]); X[B+2]=EX(X[B+2]); X[B+3]=EX(X[B+3]); PIN(X); SBAR(); }while(0)
  #define VRD(i) do{ vlo[i]=vtr(vp_+(((i)>>2)*4096+((i)&3)*1024)); vhi[i]=vtr(vp_+(((i)>>2)*4096+((i)&3)*1024+512)); }while(0)
  #define KRD(G,j) do{ if(G){ kload2(kf,kp0+sl_next,j); SBAR(); } }while(0)
  #define STEP(C0,C1,P0,P1,t,GK,GV,GL) do{ KBSUB(C0,C1); SBAR(); \
    const lds_cptr vp_=vp0+sl_prev; \
    VRD(0); SBAR(); float sacc=(P0[0]+P0[1]); \
    GAPA(C0=__builtin_amdgcn_mfma_f32_32x32x16_bf16(kf[0],qr[0],C0,0,0,0), P0[2],P0[3],P0[4],P0[5],     pw0[0]=PKW(P0,0), pw0[1]=PKW(P0,2), pw0); \
    VRD(4); SBAR(); GAPA(C1=__builtin_amdgcn_mfma_f32_32x32x16_bf16(kf[1],qr[0],C1,0,0,0), P0[6],P0[7],P0[8],P0[9],     pw0[2]=PKW(P0,4), pw0[3]=PKW(P0,6), pw0); \
    VRD(1); SBAR(); GAPA(C0=__builtin_amdgcn_mfma_f32_32x32x16_bf16(kf[2],qr[1],C0,0,0,0),   P0[10],P0[11],P0[12],P0[13], pw1[0]=PKW(P0,8), pw1[1]=PKW(P0,10), pw1); \
    VRD(5); SBAR(); GAPA(C1=__builtin_amdgcn_mfma_f32_32x32x16_bf16(kf[3],qr[1],C1,0,0,0),   P0[14],P0[15],P1[0],P1[1],   pw1[2]=PKW(P0,12),pw1[3]=PKW(P0,14), pw1); \
    VRD(2); SBAR(); GAPA(C0=__builtin_amdgcn_mfma_f32_32x32x16_bf16(kf[4],qr[2],C0,0,0,0),   P1[2],P1[3],P1[4],P1[5],     pw2[0]=PKW(P1,0), pw2[1]=PKW(P1,2), pw2); \
    VRD(6); SBAR(); GAPA(C1=__builtin_amdgcn_mfma_f32_32x32x16_bf16(kf[5],qr[2],C1,0,0,0),   P1[6],P1[7],P1[8],P1[9],     pw2[2]=PKW(P1,4), pw2[3]=PKW(P1,6), pw2); \
    VRD(3); SBAR(); GAPA(C0=__builtin_amdgcn_mfma_f32_32x32x16_bf16(kf[6],qr[3],C0,0,0,0),   P1[10],P1[11],P1[12],P1[13], pw3[0]=PKW(P1,8), pw3[1]=PKW(P1,10), pw3); \
    VRD(7); SBAR(); GAPA(C1=__builtin_amdgcn_mfma_f32_32x32x16_bf16(kf[7],qr[3],C1,0,0,0),   P1[14],P1[15],0.f,0.f,       pw3[2]=PKW(P1,12),pw3[3]=PKW(P1,14), pw3); \
    l_reg+=sacc; if((t)+1<NT){ KBLOAD(P0,P1,(t)+1); } \
    if(GK){DMA_K((t)+3,sl_cur);} if(GV){DMA_V((t)+1,sl_next);} \
    CMASK(C0,C1,t); \
    { float a=MX3(C0[0],C0[1],C1[0]),b=MX3(C0[2],C0[3],C1[1]); a=MX3(a,C1[2],C1[3]); \
      _Pragma("unroll") for(int r=4;r<16;r+=4){a=MX3(a,C0[r],C0[r+1]);b=MX3(b,C0[r+2],C0[r+3]);a=MX3(a,C1[r],C1[r+1]);b=MX3(b,C1[r+2],C1[r+3]);} \
      float rm=__builtin_fmaxf(a,b); { auto rr=__builtin_amdgcn_permlane32_swap(__float_as_uint(rm),__float_as_uint(rm),false,false); rm=__builtin_fmaxf(__uint_as_float(rr[0]),__uint_as_float(rr[1])); } \
      resc=false; \
      if(__builtin_expect(__any(rm>(float)THRL),0)){ const float dl=__builtin_fmaxf(rm,0.f); mhat+=dl; \
        _Pragma("unroll") for(int r=0;r<16;++r){C0[r]-=dl;C1[r]-=dl;} \
        const float f=__builtin_amdgcn_exp2f(-dl); l_reg*=f; if(hi==0)wsf[r32]=f; resc=true; } } \
    SBAR(); \
    GAPB(o[0]=__builtin_amdgcn_mfma_f32_32x32x16_bf16(PAF(0),VFR(0),o[0],0,0,0), C0,0); \
    GAPB(o[1]=__builtin_amdgcn_mfma_f32_32x32x16_bf16(PAF(0),VFR(4),o[1],0,0,0), C0,4); \
    KRD(GL,0); GAPB(o[0]=__builtin_amdgcn_mfma_f32_32x32x16_bf16(PAF(1),VFR(1),o[0],0,0,0), C0,8); \
    KRD(GL,1); GAPB(o[1]=__builtin_amdgcn_mfma_f32_32x32x16_bf16(PAF(1),VFR(5),o[1],0,0,0), C0,12); \
    KRD(GL,2); GAPB(o[0]=__builtin_amdgcn_mfma_f32_32x32x16_bf16(PAF(2),VFR(2),o[0],0,0,0), C1,0); \
    KRD(GL,3); GAPB(o[1]=__builtin_amdgcn_mfma_f32_32x32x16_bf16(PAF(2),VFR(6),o[1],0,0,0), C1,4); \
    GAPB(o[0]=__builtin_amdgcn_mfma_f32_32x32x16_bf16(PAF(3),VFR(3),o[0],0,0,0), C1,8); \
    GAPB(o[1]=__builtin_amdgcn_mfma_f32_32x32x16_bf16(PAF(3),VFR(7),o[1],0,0,0), C1,12); \
    }while(0)
  int t=1; KBLOAD(pB0,pB1,1);
  #undef CMASK
  #define CMASK(P0,P1,t) do{}while(0)
  for(;t+5<NT;t+=2){
    STEP(pB0,pB1,pA0,pA1,t,true,true,true);     WAIT_BAR(2); RESC(); ROT();
    STEP(pA0,pA1,pB0,pB1,t+1,true,true,true);   WAIT_BAR(2); RESC(); ROT();
  }
  #undef CMASK
  #define CMASK(P0,P1,t) do{int jb_=(t)-(NT-4); if(jb_>=0)cmask(P0,P1,jb_,qrel,hi);}while(0)
  #define ENDW(tt) do{ if((tt)+3<NT){WAIT_BAR(2);} else if((tt)+2<NT){WAIT_BAR(1);} else {WAIT_BAR(0);} }while(0)
  for(;t+1<NT;t+=2){
    STEP(pB0,pB1,pA0,pA1,t,(t+3<NT),(t+1<NT),(t+1<NT));       ENDW(t);   RESC(); ROT();
    STEP(pA0,pA1,pB0,pB1,t+1,(t+4<NT),(t+2<NT),(t+2<NT));     ENDW(t+1); RESC(); ROT();
  }
  STEP(pB0,pB1,pA0,pA1,NT-1,false,false,false); RESC();
  { float sacc=pB0[0]+pB0[1]; _Pragma("unroll") for(int r=2;r<16;++r)sacc+=pB0[r]; _Pragma("unroll") for(int r=0;r<16;++r)sacc+=pB1[r]; l_reg+=sacc;
    pw0=(u32x4){PKW(pB0,0),PKW(pB0,2),PKW(pB0,4),PKW(pB0,6)};pw1=(u32x4){PKW(pB0,8),PKW(pB0,10),PKW(pB0,12),PKW(pB0,14)};pw2=(u32x4){PKW(pB1,0),PKW(pB1,2),PKW(pB1,4),PKW(pB1,6)};pw3=(u32x4){PKW(pB1,8),PKW(pB1,10),PKW(pB1,12),PKW(pB1,14)};
    SBAR(); pv(o,vb0+sl_cur,PAF(0),PAF(1),PAF(2),PAF(3)); }
  #undef PKW
  #undef PAF
  #undef VFR
  #undef PIN
  #undef MX3
  #undef GAPA
  #undef GAPB
  #undef EX
  #undef VRD
  #undef KRD
  #undef STEP
  #undef ENDW
  {auto rr=__builtin_amdgcn_permlane32_swap(__float_as_uint(l_reg),__float_as_uint(l_reg),false,false);l_reg=__uint_as_float(rr[0])+__uint_as_float(rr[1]);}
  if(hi==0)wsf[32+r32]=l_reg;asm volatile("s_waitcnt lgkmcnt(0)":::"memory");
  float rli[16];
  #pragma unroll
  for(int r=0;r<16;++r)rli[r]=__builtin_amdgcn_rcpf(wsf[32+crow(r,hi)]);
  bf16*Ow=O+(rowbase+q0+wid*QBLK)*DM+h*D;
  { bf16*stg=(bf16*)(shm+LDS_OST)+wid*2048;
    #pragma unroll
    for(int r=0;r<16;++r){const int orow=crow(r,hi);
      #pragma unroll
      for(int d0=0;d0<2;++d0)stg[orow*64+d0*32+r32]=__float2bfloat16(o[d0][r]*rli[r]);}
    asm volatile("s_waitcnt lgkmcnt(0)":::"memory");
    #pragma unroll
    for(int i=0;i<4;++i){const int row=i*8+(lane>>3),ch=lane&7; const u32x4 v=*(const u32x4*)(stg+row*64+ch*8); ATTN_STORE16(Ow+(long)row*DM+ch*8,v);} }
  asm volatile("s_waitcnt lgkmcnt(0)\n\ts_barrier":::"memory");
  #undef DMA_K
  #undef DMA_V
  #undef CMASK
  #undef START
  #undef RESC
  #undef ROT
  #undef KBINIT
  #undef KBLOAD
  #undef KBSUB
}
constexpr int ATTN_LDS_BYTES=LDS_BYTES;
struct AttnTensors { const bf16* Q; const bf16* K; const bf16* V; bf16* O; };
struct AttnUnit { int bh; int qb; };
struct StaticOrder {
  int vcu;
  __device__ __forceinline__ explicit StaticOrder(int grid,int block):vcu((block%8)*(grid/8)+block/8){}
  __device__ __forceinline__ bool next(int i,AttnUnit&u)const{ if(i>=8)return false; const int s=4*(vcu&1)+(i>>1); u.bh=vcu>>1; u.qb=(i&1)?15-s:s; return true; }
  __device__ __forceinline__ void a_ready(const AttnUnit&)const{}
  __device__ __forceinline__ void done(const AttnUnit&)const{}
};
template<class Sched,int THRL=8> __device__ __forceinline__ void attn_phase(char*lds,const AttnTensors&T,const Sched&S,lds_fptr kbl){
  AttnUnit u;
  for(int i=0;S.next(i,u);++i){ S.a_ready(u); attn_unit<THRL>(u.bh/NHEAD,u.bh%NHEAD,u.qb,T.Q,T.K,T.V,T.O,lds,kbl); S.done(u); }
}
#undef SBAR
#undef WAIT_BAR
}
#define GAS __attribute__((address_space(1)))
#define LAS __attribute__((address_space(3)))
typedef unsigned short bf16;
typedef unsigned v4u __attribute__((ext_vector_type(4)));
typedef float f32x4 __attribute__((ext_vector_type(4)));
typedef short bf16x8 __attribute__((ext_vector_type(8)));
typedef GAS unsigned gu32;
typedef GAS unsigned long long gu64;
#define RLX_AGENT __ATOMIC_RELAXED, __HIP_MEMORY_SCOPE_AGENT
#define LDS_WAIT() asm volatile("s_waitcnt lgkmcnt(0)" ::: "memory")
#define VM_WAIT() asm volatile("s_waitcnt vmcnt(0)" ::: "memory")
__device__ __forceinline__ unsigned long long rt() { return __builtin_amdgcn_s_memrealtime(); }
__device__ __forceinline__ unsigned f2bf(float f) { unsigned u = __builtin_bit_cast(unsigned, f); return (u + 0x7fffu + ((u >> 16) & 1u)) >> 16; }
__device__ __forceinline__ unsigned pk2(float lo, float hi) { return f2bf(lo) | (f2bf(hi) << 16); }

#define XB_TMO      128
#define XB_XCNT(j)  (256  + 64 * (j))
#define XB_XSUB(j)  (1280 + 64 * (j))
#define XB_XGEN(j)  (2304 + 64 * (j))
#define XB_TOP      3328
#define XB_TOPGEN   3392
#define XCD_BAR_WORDS 3456
#define XB_SPIN_CAP (1u << 18)

__device__ __forceinline__ unsigned xb_ld(unsigned* p)              { return __hip_atomic_load(p, __ATOMIC_RELAXED, __HIP_MEMORY_SCOPE_AGENT); }
__device__ __forceinline__ unsigned xb_add(unsigned* p, unsigned v) { return __hip_atomic_fetch_add(p, v, __ATOMIC_RELAXED, __HIP_MEMORY_SCOPE_AGENT); }
__device__ __forceinline__ unsigned xb_xcc_id() { return (unsigned)__builtin_amdgcn_s_getreg((3 << 11) | 20) & 0xFu; }
#define XB_SPIN(cond, bar) do { unsigned _sp = 0; while (cond) { __builtin_amdgcn_s_sleep(1); \
    if ((++_sp & 255u) == 0u) { if (xb_ld(&(bar)[XB_TMO])) break; if (_sp > XB_SPIN_CAP) { atomicAdd(&(bar)[XB_TMO], 1u); break; } } } } while (0)

struct XcdBarrier {
    unsigned* bar; unsigned x;
    volatile LAS unsigned* st;
};

__device__ __forceinline__ XcdBarrier xcd_barrier_post(unsigned* bar, volatile LAS unsigned* st) {
    XcdBarrier b; b.bar = bar; b.x = xb_xcc_id(); b.st = st;
    if (threadIdx.x == 0) (void)xb_add(&bar[XB_XCNT(b.x)], 1u);
    return b;
}
__device__ __forceinline__ void xcd_barrier_complete(unsigned* bar, unsigned x, unsigned& nloc, unsigned& nx) {
    const unsigned G = gridDim.x * gridDim.y * gridDim.z;
    unsigned sum, cnt, mine, sp = 0u;
    for (;;) {
        sum = 0u; cnt = 0u; mine = 0u;
#pragma unroll
        for (unsigned j = 0; j < 16; ++j) { const unsigned c = xb_ld(&bar[XB_XCNT(j)]); sum += c; cnt += (c > 0u) ? 1u : 0u; mine = (j == x) ? c : mine; }
        if (sum == G) break;
        __builtin_amdgcn_s_sleep(1);
        if ((++sp & 255u) == 0u) { if (xb_ld(&bar[XB_TMO])) break; if (sp > XB_SPIN_CAP) { atomicAdd(&bar[XB_TMO], 1u); break; } }
    }
    nloc = mine > 0u ? mine : 1u; nx = cnt > 0u ? cnt : 1u;
}

__device__ __forceinline__ void xcd_barrier(const XcdBarrier& b) {
    asm volatile("s_waitcnt vmcnt(0)" ::: "memory");
    __syncthreads();
    if (threadIdx.x == 0) {
        unsigned* bar = b.bar; const unsigned myx = xb_xcc_id();
        __builtin_amdgcn_s_waitcnt(0);
        unsigned nloc = b.st[0], nx = b.st[1];
        if (nloc == 0u) { xcd_barrier_complete(bar, myx, nloc, nx); b.st[0] = nloc; b.st[1] = nx; }
        const unsigned old = xb_add(&bar[XB_XSUB(myx)], 1u);
        const unsigned gen = old / nloc;
        if (old + 1u == (gen + 1u) * nloc) {
            __builtin_amdgcn_fence(__ATOMIC_RELEASE, "agent");
            asm volatile("s_waitcnt vmcnt(0)" ::: "memory");
            const unsigned og = xb_add(&bar[XB_TOP], 1u);
            const unsigned tg = og / nx;
            if (og + 1u == (tg + 1u) * nx) xb_add(&bar[XB_TOPGEN], 1u);
            else XB_SPIN(xb_ld(&bar[XB_TOPGEN]) == tg, bar);
            __builtin_amdgcn_fence(__ATOMIC_ACQUIRE, "agent");
            xb_add(&bar[XB_XGEN(myx)], 1u);
            asm volatile("s_waitcnt vmcnt(0)" ::: "memory");
        } else {
            XB_SPIN(xb_ld(&bar[XB_XGEN(myx)]) == gen, bar);
            __builtin_amdgcn_fence(__ATOMIC_ACQUIRE, "agent");
            asm volatile("s_waitcnt vmcnt(0)" ::: "memory");
        }
    }
    __syncthreads();
}

constexpr int NWAVES = 8, NTHR = 512;
constexpr int NB = 8, SEQ = 4096, D = 1024, M = NB * SEQ, NH = 16;
constexpr int NEXP = 16384, NSEL = 128;
constexpr float LN_EPS = 1e-5f;
constexpr float DN_ALPHA = 1.41421356237309515f;
constexpr int NAI = 3088, NAI_PAD = 3328;

constexpr size_t MiB = 1u << 20;
constexpr size_t WS_CTL = 0, CTL_ZERO_BYTES = 1 * MiB;
constexpr size_t WS_MOD = 512 * 1024;
constexpr size_t WS_SKB = 1 * MiB;
constexpr size_t WS_LOGF = 2 * MiB;
constexpr size_t WS_WCI = 8 * MiB, WS_WCO = 12 * MiB, WS_WAI = 14 * MiB, WS_WAO = 21 * MiB, WS_WPQ = 23 * MiB;
constexpr size_t WS_SC = 4 * MiB;
constexpr size_t WS_EXP = 32 * MiB;
constexpr size_t WS_HB = 160 * MiB;
constexpr size_t WS_BIG = 224 * MiB;
constexpr size_t WS_IDX = 416 * MiB, WS_GATE = 432 * MiB, WS_HB8 = 448 * MiB, WS_HS = 480 * MiB, WS_WCI8 = 481 * MiB, WS_WAI8 = 483 * MiB, WS_WPQ8 = 487 * MiB, WS_WSC = 491 * MiB, WS_WCO8 = 491 * MiB + 512 * 1024, WS_END = 493 * MiB;
constexpr int CW_BAR = 4096;

constexpr int RING_OFF = 0, RING_BYTES = 131072;
constexpr int LDSCTL_OFF = RING_BYTES, MISC_OFF = LDSCTL_OFF + 320;
constexpr int LDS_BYTES = 147456;
constexpr int KB_OFF = 98304;

#ifndef NREP_GEMM
#define NREP_GEMM 1
#endif
#ifndef NREP_TOPK
#define NREP_TOPK 1
#endif
#ifndef NREP_ATTN
#define NREP_ATTN 1
#endif
#ifndef NREP_GATHER
#define NREP_GATHER 1
#endif
#ifndef NREP_CONV
#define NREP_CONV 1
#endif
#ifndef NREP_PU
#define NREP_PU 1
#endif
#ifndef NREP_PV
#define NREP_PV 1
#endif
#ifndef PHM
#define PHM 0xFFFF
#endif
struct Args { const float* in[27]; float* out; unsigned char* ws; };

__device__ __forceinline__ float wave_sum(float v) {
#pragma unroll
    for (int o = 1; o < 64; o <<= 1) v += __shfl_xor(v, o);
    return v;
}
template <int CTRL> __device__ __forceinline__ float dpp_f(float v) { return __uint_as_float((unsigned)__builtin_amdgcn_update_dpp(0, (int)__float_as_uint(v), CTRL, 0xF, 0xF, true)); }
__device__ __forceinline__ float wave_max_nl(float v) {
    v = fmaxf(v, dpp_f<0x128>(v)); v = fmaxf(v, dpp_f<0x124>(v)); v = fmaxf(v, dpp_f<0x122>(v)); v = fmaxf(v, dpp_f<0x121>(v));
    v = fmaxf(v, __uint_as_float((unsigned)__builtin_amdgcn_ds_swizzle((int)__float_as_uint(v), 0x401F)));
    auto rr = __builtin_amdgcn_permlane32_swap(__float_as_uint(v), __float_as_uint(v), false, false);
    return fmaxf(__uint_as_float(rr[0]), __uint_as_float(rr[1]));
}
__device__ __forceinline__ float bf_lo(unsigned w) { return __uint_as_float(w << 16); }
__device__ __forceinline__ float bf_hi(unsigned w) { return __uint_as_float(w & 0xffff0000u); }
__device__ __forceinline__ float sigmoidf_(float x) { return 1.f / (1.f + __expf(-x)); }

namespace pg8 {
struct EpiGlu {
    static constexpr bool PERM = true, AFTER_DRAIN = false;
    bf16_t* O; const float* bias;
    __device__ __forceinline__ void operator()(const f32x4 (&acc)[2][2][4][2], const Unit& u, int wr, int wc, int fr, int fq) const {
        const int row0 = u.pm * BM + wr * 64 + fr; const int ocol = u.pn * 128 + wc * 32 + 8 * fq;
        f32x4 bl[2], bg[2];
#pragma unroll
        for (int n = 0; n < 2; ++n) { bl[n] = *(const f32x4*)(bias + ocol + 4 * n); bg[n] = *(const f32x4*)(bias + 1024 + ocol + 4 * n); }
#pragma unroll
        for (int ai = 0; ai < 2; ++ai)
#pragma unroll
            for (int m = 0; m < 4; ++m) {
                float v[8];
#pragma unroll
                for (int n = 0; n < 2; ++n)
#pragma unroll
                    for (int i = 0; i < 4; ++i) { const float l = acc[ai][0][m][n][i] + bl[n][i], g = acc[ai][1][m][n][i] + bg[n][i]; v[4 * n + i] = l / (1.f + __expf(-g)); }
                u32x4 w; w.x = cvt_pk_bf16(v[0], v[1]); w.y = cvt_pk_bf16(v[2], v[3]); w.z = cvt_pk_bf16(v[4], v[5]); w.w = cvt_pk_bf16(v[6], v[7]);
                *(u32x4*)(O + (size_t)(row0 + ai * HALF + m * 16) * 1024 + ocol) = w;
            }
    }
};
struct EpiQkvf {
    static constexpr bool PERM = true, AFTER_DRAIN = false;
    EpiBf16<0> inner; float* logf_t; const float* bias;
    __device__ __forceinline__ void operator()(const f32x4 (&acc)[2][2][4][2], const Unit& u, int wr, int wc, int fr, int fq) const {
        if (u.pn < 12) { inner(acc, u, wr, wc, fr, fq); return; }
        if (wc == 0 && fq < 2) {
            const int row0 = u.pm * BM + wr * 64 + fr;
#pragma unroll
            for (int ai = 0; ai < 2; ++ai)
#pragma unroll
                for (int m = 0; m < 4; ++m) { const int row = row0 + ai * HALF + m * 16; const int b = row >> 12, s = row & 4095;
#pragma unroll
                    for (int n = 0; n < 2; ++n)
#pragma unroll
                        for (int i = 0; i < 4; ++i) { const int col = 8 * fq + 4 * n + i; const float v = acc[ai][0][m][n][i] + bias[3072 + col];
                            const float lf = fminf(v, 0.f) - log1pf(__expf(-fabsf(v)));
                            logf_t[((size_t)(b * 16 + col) << 12) + s] = lf; } }
        }
    }
};
__device__ __forceinline__ f32x4 cvt_i8acc(const f32x4 a, float rsv, const f32x4 csv) { typedef int v4i_t __attribute__((ext_vector_type(4))); const v4i_t t = __builtin_bit_cast(v4i_t, a);
    return (f32x4){(float)t[0], (float)t[1], (float)t[2], (float)t[3]} * rsv * csv; }
struct EpiBf16I8 {
    static constexpr bool PERM = true, AFTER_DRAIN = false;
    bf16_t* O; int ldc; const float* bias; int split_cols; size_t split_stride; float scale0; const float* rs; const float* cs;
    __device__ __forceinline__ void operator()(const f32x4 (&acc)[2][2][4][2], const Unit& u, int wr, int wc, int fr, int fq) const {
        const int row0 = u.pm * BM + wr * 64 + fr; int colt = u.pn * BM; bf16_t* base = O;
        float sc = 1.f; if (split_cols) { const int t = colt / split_cols; base += (size_t)t * split_stride; colt -= t * split_cols; if (t == 0) sc = scale0; }
        const int col0 = colt + wc * 32 + 8 * fq, bcol0 = u.pn * BM + wc * 32 + 8 * fq;
#pragma unroll
        for (int bj = 0; bj < 2; ++bj) {
            f32x4 bv[2], cv[2];
#pragma unroll
            for (int n = 0; n < 2; ++n) { bv[n] = bias ? *(const f32x4*)(bias + bcol0 + bj * HALF + 4 * n) : (f32x4){0.f, 0.f, 0.f, 0.f}; cv[n] = *(const f32x4*)(cs + bcol0 + bj * HALF + 4 * n); }
#pragma unroll
            for (int ai = 0; ai < 2; ++ai)
#pragma unroll
                for (int m = 0; m < 4; ++m) { const int row = row0 + ai * HALF + m * 16; const float rsv = rs[row]; bf16_t* rowp = base + (size_t)row * ldc + col0;
                    const f32x4 v0 = (cvt_i8acc(acc[ai][bj][m][0], rsv, cv[0]) + bv[0]) * sc, v1 = (cvt_i8acc(acc[ai][bj][m][1], rsv, cv[1]) + bv[1]) * sc;
                    u32x4 w; w.x = cvt_pk_bf16(v0[0], v0[1]); w.y = cvt_pk_bf16(v0[2], v0[3]); w.z = cvt_pk_bf16(v1[0], v1[1]); w.w = cvt_pk_bf16(v1[2], v1[3]);
                    *(u32x4*)(rowp + bj * HALF) = w; }
        }
    }
};
struct EpiPqI8 {
    static constexpr bool PERM = true, AFTER_DRAIN = false;
    bf16_t* O; const float* rs; const float* cs;
    __device__ __forceinline__ void operator()(const f32x4 (&acc)[2][2][4][2], const Unit& u, int wr, int wc, int fr, int fq) const {
        const int row0 = u.pm * BM + wr * 64 + fr; const int bcol0 = u.pn * BM + wc * 32 + 8 * fq; const int ks = 2 * wc + (fq >> 1), hi = fq & 1;
#pragma unroll
        for (int bj = 0; bj < 2; ++bj) {
            f32x4 cv[2];
#pragma unroll
            for (int n = 0; n < 2; ++n) cv[n] = *(const f32x4*)(cs + bcol0 + bj * HALF + 4 * n);
#pragma unroll
            for (int ai = 0; ai < 2; ++ai)
#pragma unroll
                for (int m = 0; m < 4; ++m) { const int row = row0 + ai * HALF + m * 16; const float rsv = rs[row];
                    const f32x4 v0 = cvt_i8acc(acc[ai][bj][m][0], rsv, cv[0]), v1 = cvt_i8acc(acc[ai][bj][m][1], rsv, cv[1]);
                    u32x4 w; w.x = cvt_pk_bf16(v0[0], v0[1]); w.y = cvt_pk_bf16(v0[2], v0[3]); w.z = cvt_pk_bf16(v1[0], v1[1]); w.w = cvt_pk_bf16(v1[2], v1[3]);
                    const size_t off = ((((((size_t)(row >> 5) * 8 + u.pn) * 2 + bj) * 8 + ks) * 2 + hi) * 32 + (row & 31)) * 8;
                    *(u32x4*)(O + off) = w; }
        }
    }
};
struct EpiGluI8 {
    static constexpr bool PERM = true, AFTER_DRAIN = false;
    bf16_t* O; const float* bias; const float* rs; const float* cs;
    __device__ __forceinline__ void operator()(const f32x4 (&acc)[2][2][4][2], const Unit& u, int wr, int wc, int fr, int fq) const {
        const int row0 = u.pm * BM + wr * 64 + fr; const int ocol = u.pn * 128 + wc * 32 + 8 * fq; const int brow0 = u.pn * BM + wc * 32 + 8 * fq;
        typedef unsigned u32x2_e __attribute__((ext_vector_type(2)));
#pragma unroll
        for (int n = 0; n < 2; ++n) {
            const f32x4 bl = *(const f32x4*)(bias + ocol + 4 * n), bg = *(const f32x4*)(bias + 1024 + ocol + 4 * n);
            const f32x4 cl = *(const f32x4*)(cs + brow0 + 4 * n), cg = *(const f32x4*)(cs + brow0 + HALF + 4 * n);
#pragma unroll
            for (int ai = 0; ai < 2; ++ai)
#pragma unroll
                for (int m = 0; m < 4; ++m) { const int row = row0 + ai * HALF + m * 16; const float rsv = rs[row];
                    const f32x4 l4 = cvt_i8acc(acc[ai][0][m][n], rsv, cl) + bl, g4 = cvt_i8acc(acc[ai][1][m][n], rsv, cg) + bg;
                    float v[4];
#pragma unroll
                    for (int i = 0; i < 4; ++i) v[i] = l4[i] / (1.f + __expf(-g4[i]));
                    *(u32x2_e*)(O + (size_t)row * 1024 + ocol + 4 * n) = (u32x2_e){cvt_pk_bf16(v[0], v[1]), cvt_pk_bf16(v[2], v[3])}; }
        }
    }
};
struct EpiQkvfI8 {
    static constexpr bool PERM = true, AFTER_DRAIN = false;
    EpiBf16I8 inner; float* logf_t; const float* bias;
    __device__ __forceinline__ void operator()(const f32x4 (&acc)[2][2][4][2], const Unit& u, int wr, int wc, int fr, int fq) const {
        if (u.pn < 12) { inner(acc, u, wr, wc, fr, fq); return; }
        if (wc == 0 && fq < 2) {
            const int row0 = u.pm * BM + wr * 64 + fr;
            const int fbase = u.pn * BM;
            f32x4 cv[2]; cv[0] = *(const f32x4*)(inner.cs + fbase + 8 * fq); cv[1] = *(const f32x4*)(inner.cs + fbase + 8 * fq + 4);
#pragma unroll
            for (int ai = 0; ai < 2; ++ai)
#pragma unroll
                for (int m = 0; m < 4; ++m) { const int row = row0 + ai * HALF + m * 16; const int b = row >> 12, s = row & 4095; const float rsv = inner.rs[row];
#pragma unroll
                    for (int n = 0; n < 2; ++n) { const f32x4 a4 = cvt_i8acc(acc[ai][0][m][n], rsv, cv[n]);
#pragma unroll
                        for (int i = 0; i < 4; ++i) { const int col = 8 * fq + 4 * n + i; const float v = a4[i] + bias[fbase + col];
                            logf_t[((size_t)(b * 16 + col) << 12) + s] = fminf(v, 0.f) - log1pf(__expf(-fabsf(v))); } } }
        }
    }
};
}

__device__ __forceinline__ void transpose_item(const float* W, int K, int ldw, bf16* WT, int k0, int n0, int dst_row0, LAS float* scr, int lane) {
    float tv[32];
#pragma unroll
    for (int i = 0; i < 32; ++i) tv[i] = W[(size_t)(k0 + 2 * i + (lane >> 5)) * ldw + n0 + (lane & 31)];
#pragma unroll
    for (int i = 0; i < 32; ++i) scr[(2 * i + (lane >> 5)) * 33 + (lane & 31)] = tv[i];
    LDS_WAIT(); asm volatile("" ::: "memory");
    const int c = lane & 7;
#pragma unroll
    for (int j = 0; j < 4; ++j) { const int n = (lane >> 3) + 8 * j; const LAS float* s = scr + (8 * c) * 33 + n;
        v4u o; o.x = pk2(s[0 * 33], s[1 * 33]); o.y = pk2(s[2 * 33], s[3 * 33]); o.z = pk2(s[4 * 33], s[5 * 33]); o.w = pk2(s[6 * 33], s[7 * 33]);
        *(GAS v4u*)(WT + (size_t)(dst_row0 + n) * K + k0 + 8 * c) = o; }
    LDS_WAIT(); asm volatile("" ::: "memory");
}

struct RowVec { float v[16]; };
__device__ __forceinline__ void load16f(const float* p, int lane, float* v) {
    const f32x4 a = *(const f32x4*)(p + 8 * lane), b = *(const f32x4*)(p + 8 * lane + 4), c = *(const f32x4*)(p + 512 + 8 * lane), d = *(const f32x4*)(p + 512 + 8 * lane + 4);
#pragma unroll
    for (int i = 0; i < 4; ++i) { v[i] = a[i]; v[4 + i] = b[i]; v[8 + i] = c[i]; v[12 + i] = d[i]; }
}
__device__ __forceinline__ void store16f(float* p, int lane, const float* v) {
    *(f32x4*)(p + 8 * lane) = (f32x4){v[0], v[1], v[2], v[3]}; *(f32x4*)(p + 8 * lane + 4) = (f32x4){v[4], v[5], v[6], v[7]};
    *(f32x4*)(p + 512 + 8 * lane) = (f32x4){v[8], v[9], v[10], v[11]}; *(f32x4*)(p + 512 + 8 * lane + 4) = (f32x4){v[12], v[13], v[14], v[15]};
}
__device__ __forceinline__ void store16bf(bf16* p, int lane, const float* v) {
    v4u a, b; a.x = pk2(v[0], v[1]); a.y = pk2(v[2], v[3]); a.z = pk2(v[4], v[5]); a.w = pk2(v[6], v[7]);
    b.x = pk2(v[8], v[9]); b.y = pk2(v[10], v[11]); b.z = pk2(v[12], v[13]); b.w = pk2(v[14], v[15]);
    *(v4u*)(p + 8 * lane) = a; *(v4u*)(p + 512 + 8 * lane) = b;
}
__device__ __forceinline__ unsigned pack_i8x4(float a, float b, float c, float d) {
    int q0 = __float2int_rn(a), q1 = __float2int_rn(b), q2 = __float2int_rn(c), q3 = __float2int_rn(d);
    q0 = max(-127, min(127, q0)); q1 = max(-127, min(127, q1)); q2 = max(-127, min(127, q2)); q3 = max(-127, min(127, q3));
    return ((unsigned)q0 & 255u) | (((unsigned)q1 & 255u) << 8) | (((unsigned)q2 & 255u) << 16) | (((unsigned)q3 & 255u) << 24);
}
__device__ __forceinline__ void store_row_i8(const float* x, unsigned char* hb8_row, float* hs_ptr, int lane) {
    float am = 0.f;
#pragma unroll
    for (int i = 0; i < 16; ++i) am = fmaxf(am, fabsf(x[i]));
    am = wave_max_nl(am);
    const float sc = (am > 0.f) ? am * (1.f / 127.f) : 1.f, inv = 1.f / sc;
    const unsigned w0 = pack_i8x4(x[0] * inv, x[1] * inv, x[2] * inv, x[3] * inv), w1 = pack_i8x4(x[4] * inv, x[5] * inv, x[6] * inv, x[7] * inv);
    const unsigned w2 = pack_i8x4(x[8] * inv, x[9] * inv, x[10] * inv, x[11] * inv), w3 = pack_i8x4(x[12] * inv, x[13] * inv, x[14] * inv, x[15] * inv);
    typedef unsigned u32x2_t __attribute__((ext_vector_type(2)));
    *(u32x2_t*)(hb8_row + 8 * lane) = (u32x2_t){w0, w1}; *(u32x2_t*)(hb8_row + 512 + 8 * lane) = (u32x2_t){w2, w3};
    if (lane == 0) *hs_ptr = sc;
}
__device__ __forceinline__ void resid_ln_row_pre(float* x, const float* y, const float* modg, const float* lng, const float* lnb,
                                                 float* xout_row, bf16* hb_row, const float* modn, int lane, unsigned char* hb8_row = nullptr, float* hs_ptr = nullptr, bool write_bf = true) {
    float g[16];
    load16f(modg, lane, g);
    float s = 0.f;
#pragma unroll
    for (int i = 0; i < 16; ++i) { x[i] = DN_ALPHA * x[i] + g[i] * y[i]; s += x[i]; }
    const float mean = wave_sum(s) * (1.f / D); float q = 0.f;
#pragma unroll
    for (int i = 0; i < 16; ++i) { x[i] -= mean; q += x[i] * x[i]; }
    const float rstd = 1.f / sqrtf(wave_sum(q) * (1.f / D) + LN_EPS);
    load16f(lng, lane, g);
#pragma unroll
    for (int i = 0; i < 16; ++i) x[i] = x[i] * rstd * g[i];
    load16f(lnb, lane, g);
#pragma unroll
    for (int i = 0; i < 16; ++i) x[i] += g[i];
    store16f(xout_row, lane, x);
    if (modn) {
        load16f(modn + 1024, lane, g);
#pragma unroll
        for (int i = 0; i < 16; ++i) x[i] = x[i] * (1.f + g[i]);
        load16f(modn, lane, g);
#pragma unroll
        for (int i = 0; i < 16; ++i) x[i] += g[i];
        if (write_bf) store16bf(hb_row, lane, x);
        if (hb8_row) store_row_i8(x, hb8_row, hs_ptr, lane);
    }
}
__device__ __forceinline__ void resid_ln_row(const float* xin_row, const float* y, const float* modg  , const float* lng, const float* lnb,
                                             float* xout_row, bf16* hb_row, const float* modn  , int lane) {
    float x[16], g[16];
    load16f(xin_row, lane, x); load16f(modg, lane, g);
    float s = 0.f;
#pragma unroll
    for (int i = 0; i < 16; ++i) { x[i] = DN_ALPHA * x[i] + g[i] * y[i]; s += x[i]; }
    const float mean = wave_sum(s) * (1.f / D); float q = 0.f;
#pragma unroll
    for (int i = 0; i < 16; ++i) { x[i] -= mean; q += x[i] * x[i]; }
    const float rstd = 1.f / sqrtf(wave_sum(q) * (1.f / D) + LN_EPS);
    load16f(lng, lane, g);
#pragma unroll
    for (int i = 0; i < 16; ++i) x[i] = x[i] * rstd * g[i];
    load16f(lnb, lane, g);
#pragma unroll
    for (int i = 0; i < 16; ++i) x[i] += g[i];
    store16f(xout_row, lane, x);
    if (modn) {
        load16f(modn + 1024, lane, g);
#pragma unroll
        for (int i = 0; i < 16; ++i) x[i] = x[i] * (1.f + g[i]);
        load16f(modn, lane, g);
#pragma unroll
        for (int i = 0; i < 16; ++i) x[i] += g[i];
        store16bf(hb_row, lane, x);
    }
}

__device__ __forceinline__ unsigned f2key(float f) { const unsigned u = __float_as_uint(f); return u ^ ((unsigned)((int)u >> 31) | 0x80000000u); }
__device__ __forceinline__ float key2f(unsigned k) { const unsigned u = (k & 0x80000000u) ? (k ^ 0x80000000u) : ~k; return __uint_as_float(u); }
#define CE_DESC(x, y) do { const unsigned mx_ = (x) > (y) ? (x) : (y), mn_ = (x) > (y) ? (y) : (x); (x) = mx_; (y) = mn_; } while (0)
template <int O> __device__ __forceinline__ void sort16_desc(unsigned (&a)[64]) {
    CE_DESC(a[O + 0], a[O + 1]); CE_DESC(a[O + 2], a[O + 3]); CE_DESC(a[O + 0], a[O + 2]); CE_DESC(a[O + 1], a[O + 3]); CE_DESC(a[O + 1], a[O + 2]); CE_DESC(a[O + 4], a[O + 5]);
    CE_DESC(a[O + 6], a[O + 7]); CE_DESC(a[O + 4], a[O + 6]); CE_DESC(a[O + 5], a[O + 7]); CE_DESC(a[O + 5], a[O + 6]); CE_DESC(a[O + 0], a[O + 4]); CE_DESC(a[O + 2], a[O + 6]);
    CE_DESC(a[O + 2], a[O + 4]); CE_DESC(a[O + 1], a[O + 5]); CE_DESC(a[O + 3], a[O + 7]); CE_DESC(a[O + 3], a[O + 5]); CE_DESC(a[O + 1], a[O + 2]); CE_DESC(a[O + 3], a[O + 4]);
    CE_DESC(a[O + 5], a[O + 6]); CE_DESC(a[O + 8], a[O + 9]); CE_DESC(a[O + 10], a[O + 11]); CE_DESC(a[O + 8], a[O + 10]); CE_DESC(a[O + 9], a[O + 11]); CE_DESC(a[O + 9], a[O + 10]);
    CE_DESC(a[O + 12], a[O + 13]); CE_DESC(a[O + 14], a[O + 15]); CE_DESC(a[O + 12], a[O + 14]); CE_DESC(a[O + 13], a[O + 15]); CE_DESC(a[O + 13], a[O + 14]); CE_DESC(a[O + 8], a[O + 12]);
    CE_DESC(a[O + 10], a[O + 14]); CE_DESC(a[O + 10], a[O + 12]); CE_DESC(a[O + 9], a[O + 13]); CE_DESC(a[O + 11], a[O + 15]); CE_DESC(a[O + 11], a[O + 13]); CE_DESC(a[O + 9], a[O + 10]);
    CE_DESC(a[O + 11], a[O + 12]); CE_DESC(a[O + 13], a[O + 14]); CE_DESC(a[O + 0], a[O + 8]); CE_DESC(a[O + 4], a[O + 12]); CE_DESC(a[O + 4], a[O + 8]); CE_DESC(a[O + 2], a[O + 10]);
    CE_DESC(a[O + 6], a[O + 14]); CE_DESC(a[O + 6], a[O + 10]); CE_DESC(a[O + 2], a[O + 4]); CE_DESC(a[O + 6], a[O + 8]); CE_DESC(a[O + 10], a[O + 12]); CE_DESC(a[O + 1], a[O + 9]);
    CE_DESC(a[O + 5], a[O + 13]); CE_DESC(a[O + 5], a[O + 9]); CE_DESC(a[O + 3], a[O + 11]); CE_DESC(a[O + 7], a[O + 15]); CE_DESC(a[O + 7], a[O + 11]); CE_DESC(a[O + 3], a[O + 5]);
    CE_DESC(a[O + 7], a[O + 9]); CE_DESC(a[O + 11], a[O + 13]); CE_DESC(a[O + 1], a[O + 2]); CE_DESC(a[O + 3], a[O + 4]); CE_DESC(a[O + 5], a[O + 6]); CE_DESC(a[O + 7], a[O + 8]);
    CE_DESC(a[O + 9], a[O + 10]); CE_DESC(a[O + 11], a[O + 12]); CE_DESC(a[O + 13], a[O + 14]);
}
template <int O> __device__ __forceinline__ void bmerge16_desc(unsigned (&a)[64]) {
#pragma unroll
    for (int lj = 3; lj >= 0; --lj)
#pragma unroll
        for (int i = 0; i < 16; ++i) { const int j = 1 << lj, l = i ^ j; if (l > i) CE_DESC(a[O + i], a[O + l]); }
}
template <int OA, int OB> __device__ __forceinline__ void topmerge16(unsigned (&a)[64]) {
#pragma unroll
    for (int i = 0; i < 16; ++i) { const unsigned x = a[OA + i], y = a[OB + 15 - i]; a[OA + i] = x > y ? x : y; }
    bmerge16_desc<OA>(a);
}
__device__ __forceinline__ void top16_of_64(unsigned (&a)[64]) {
    sort16_desc<0>(a); sort16_desc<16>(a); sort16_desc<32>(a); sort16_desc<48>(a);
    topmerge16<0, 16>(a); topmerge16<32, 48>(a); topmerge16<0, 32>(a);
}
__host__ __device__ constexpr bool pk_valid(int i, int j) { return (i + 1) * (j + 1) <= 16; }
__host__ __device__ constexpr int pk_pos(int i, int j) { int n = 0; for (int a = 0; a < 16; ++a) for (int b = 0; b < 16; ++b) { if (a == i && b == j) return n; if (pk_valid(a, b)) ++n; } return n; }
static_assert(pk_pos(15, 1) == 50, "50 candidate pairs");

template <int IJ> __device__ __forceinline__ void fill_cand(unsigned (&c)[64], const float (&v1)[16], const float (&v2)[16]) {
    if constexpr (IJ < 256) { constexpr int i = IJ >> 4, j = IJ & 15;
        if constexpr (pk_valid(i, j)) { constexpr int p = pk_pos(i, j); c[p] = (f2key(v1[i] + v2[j]) & ~0xFFu) | (unsigned)(i * 16 + j); }
        fill_cand<IJ + 1>(c, v1, v2); }
}
__device__ __forceinline__ void peer_half_top16(const bf16x8 (&bq)[8], const LAS bf16x8* skf  , int lane, int hi, unsigned (&L)[16]) {
    using attn_body::f32x16;
    f32x16 acc[4]; acc[0] = f32x16{}; acc[1] = f32x16{}; acc[2] = f32x16{}; acc[3] = f32x16{};
#pragma unroll
    for (int ks = 0; ks < 8; ++ks) {
#pragma unroll
        for (int kb = 0; kb < 4; ++kb) { const bf16x8 ak = skf[(kb * 8 + ks) * 64 + lane];
            acc[kb] = __builtin_amdgcn_mfma_f32_32x32x16_bf16(ak, bq[ks], acc[kb], 0, 0, 0); }
    }
    unsigned a[64];
#pragma unroll
    for (int kb = 0; kb < 4; ++kb)
#pragma unroll
        for (int r = 0; r < 16; ++r) a[kb * 16 + r] = (f2key(acc[kb][r]) & ~0x7Fu) | (unsigned)(kb * 32 + (r & 3) + 8 * (r >> 2));
    top16_of_64(a);
    const unsigned hi4 = (unsigned)hi << 2;
#pragma unroll
    for (int i = 0; i < 16; ++i) { a[i] |= hi4;
        auto rr = __builtin_amdgcn_permlane32_swap(a[i], a[i], false, false); a[16 + i] = hi ? rr[0] : rr[1]; }
    topmerge16<0, 16>(a);
#pragma unroll
    for (int i = 0; i < 16; ++i) L[i] = a[i];
}
__device__ __forceinline__ unsigned byte_lookup(unsigned long long lo, unsigned long long hi8, unsigned i) {
    const unsigned long long s = (i & 8u) ? hi8 : lo; return (unsigned)(s >> ((i & 7u) * 8u)) & 0x7Fu;
}
__device__ __forceinline__ void peer_topk_item(const bf16* PQ, const LAS bf16x8* skf  , unsigned* IDX, float* GATE, int tb, int head, int lane) {
    const int r32 = lane & 31, hi = lane >> 5; const int t0 = tb * 32;
    unsigned L1[16], L2[16];
    bf16x8 bq0[8], bq1[8];
    { const bf16* pr = PQ + ((size_t)(tb * 8 + head) * 2) * 8 * 512 + (size_t)lane * 8;
#pragma unroll
      for (int ks = 0; ks < 8; ++ks) { bq0[ks] = *(const bf16x8*)(pr + ks * 512); bq1[ks] = *(const bf16x8*)(pr + 8 * 512 + ks * 512); } }
    __builtin_amdgcn_sched_barrier(0);
    peer_half_top16(bq0, skf, lane, hi, L1);
    peer_half_top16(bq1, skf + 4 * 8 * 64, lane, hi, L2);
    float v1[16], v2[16]; unsigned long long p1lo = 0, p1hi = 0, p2lo = 0, p2hi = 0;
#pragma unroll
    for (int i = 0; i < 16; ++i) { v1[i] = key2f(L1[i] & ~0x7Fu); v2[i] = key2f(L2[i] & ~0x7Fu);
        const unsigned long long b1 = (unsigned long long)(L1[i] & 0x7Fu) << ((i & 7) * 8), b2 = (unsigned long long)(L2[i] & 0x7Fu) << ((i & 7) * 8);
        if (i < 8) { p1lo |= b1; p2lo |= b2; } else { p1hi |= b1; p2hi |= b2; } }
    unsigned c[64];
    fill_cand<0>(c, v1, v2);
#pragma unroll
    for (int i = 50; i < 64; ++i) c[i] = 0u;
    sort16_desc<0>(c); sort16_desc<16>(c); sort16_desc<32>(c); CE_DESC(c[48], c[49]);
    topmerge16<0, 16>(c); topmerge16<32, 48>(c); topmerge16<0, 32>(c);
    float sc[16], e[16]; unsigned ex[16]; float sum = 0.f;
#pragma unroll
    for (int k = 0; k < 16; ++k) { const unsigned id = c[k] & 0xFFu; sc[k] = key2f(c[k] & ~0xFFu);
        ex[k] = byte_lookup(p1lo, p1hi, id >> 4) * 128u + byte_lookup(p2lo, p2hi, id & 15u); }
#pragma unroll
    for (int k = 0; k < 16; ++k) { e[k] = __expf(sc[k] - sc[0]); sum += e[k]; }
    const float rs = 1.f / sum;
    v4u i0, i1; f32x4 g0, g1;
    i0.x = hi ? ex[8] : ex[0]; i0.y = hi ? ex[9] : ex[1]; i0.z = hi ? ex[10] : ex[2]; i0.w = hi ? ex[11] : ex[3];
    i1.x = hi ? ex[12] : ex[4]; i1.y = hi ? ex[13] : ex[5]; i1.z = hi ? ex[14] : ex[6]; i1.w = hi ? ex[15] : ex[7];
    g0[0] = (hi ? e[8] : e[0]) * rs; g0[1] = (hi ? e[9] : e[1]) * rs; g0[2] = (hi ? e[10] : e[2]) * rs; g0[3] = (hi ? e[11] : e[3]) * rs;
    g1[0] = (hi ? e[12] : e[4]) * rs; g1[1] = (hi ? e[13] : e[5]) * rs; g1[2] = (hi ? e[14] : e[6]) * rs; g1[3] = (hi ? e[15] : e[7]) * rs;
    const size_t o = (size_t)(t0 + r32) * NSEL + head * 16 + hi * 8;
    *(v4u*)(IDX + o) = i0; *(v4u*)(IDX + o + 4) = i1; *(f32x4*)(GATE + o) = g0; *(f32x4*)(GATE + o + 4) = g1;
}

typedef float f32x2 __attribute__((ext_vector_type(2)));
__device__ __forceinline__ void load16fB(const float* p, int lane, float* v) {
    const f32x4 a = *(const f32x4*)(p + 16 * lane), b = *(const f32x4*)(p + 16 * lane + 4), c = *(const f32x4*)(p + 16 * lane + 8), d = *(const f32x4*)(p + 16 * lane + 12);
#pragma unroll
    for (int i = 0; i < 4; ++i) { v[i] = a[i]; v[4 + i] = b[i]; v[8 + i] = c[i]; v[12 + i] = d[i]; }
}
__device__ __forceinline__ void store16fB(float* p, int lane, const float* v) {
    *(f32x4*)(p + 16 * lane) = (f32x4){v[0], v[1], v[2], v[3]}; *(f32x4*)(p + 16 * lane + 4) = (f32x4){v[4], v[5], v[6], v[7]};
    *(f32x4*)(p + 16 * lane + 8) = (f32x4){v[8], v[9], v[10], v[11]}; *(f32x4*)(p + 16 * lane + 12) = (f32x4){v[12], v[13], v[14], v[15]};
}
__device__ __forceinline__ void store16bfB(bf16* p, int lane, const float* v) {
    v4u a, b; a.x = pk2(v[0], v[1]); a.y = pk2(v[2], v[3]); a.z = pk2(v[4], v[5]); a.w = pk2(v[6], v[7]);
    b.x = pk2(v[8], v[9]); b.y = pk2(v[10], v[11]); b.z = pk2(v[12], v[13]); b.w = pk2(v[14], v[15]);
    *(v4u*)(p + 16 * lane) = a; *(v4u*)(p + 16 * lane + 8) = b;
}
__device__ __forceinline__ void resid_ln_rowB(const float* xin_row, const float* y, const float* modg, const float* lng, const float* lnb,
                                              float* xout_row, bf16* hb_row, const float* modn, int lane) {
    float x[16], g[16];
    load16fB(xin_row, lane, x); load16fB(modg, lane, g);
    float s = 0.f;
#pragma unroll
    for (int i = 0; i < 16; ++i) { x[i] = DN_ALPHA * x[i] + g[i] * y[i]; s += x[i]; }
    const float mean = wave_sum(s) * (1.f / D); float q = 0.f;
#pragma unroll
    for (int i = 0; i < 16; ++i) { x[i] -= mean; q += x[i] * x[i]; }
    const float rstd = 1.f / sqrtf(wave_sum(q) * (1.f / D) + LN_EPS);
    load16fB(lng, lane, g);
#pragma unroll
    for (int i = 0; i < 16; ++i) x[i] = x[i] * rstd * g[i];
    load16fB(lnb, lane, g);
#pragma unroll
    for (int i = 0; i < 16; ++i) x[i] += g[i];
    store16fB(xout_row, lane, x);
    if (modn) {
        load16fB(modn + 1024, lane, g);
#pragma unroll
        for (int i = 0; i < 16; ++i) x[i] = x[i] * (1.f + g[i]);
        load16fB(modn, lane, g);
#pragma unroll
        for (int i = 0; i < 16; ++i) x[i] += g[i];
        store16bfB(hb_row, lane, x);
    }
}
__device__ __forceinline__ float dot16_fp8(const v4u w, const f32x2 (&h)[8]) {
    f32x2 acc = {0.f, 0.f};
    acc = __builtin_elementwise_fma(__builtin_amdgcn_cvt_pk_f32_fp8(w.x, false), h[0], acc); acc = __builtin_elementwise_fma(__builtin_amdgcn_cvt_pk_f32_fp8(w.x, true), h[1], acc);
    acc = __builtin_elementwise_fma(__builtin_amdgcn_cvt_pk_f32_fp8(w.y, false), h[2], acc); acc = __builtin_elementwise_fma(__builtin_amdgcn_cvt_pk_f32_fp8(w.y, true), h[3], acc);
    acc = __builtin_elementwise_fma(__builtin_amdgcn_cvt_pk_f32_fp8(w.z, false), h[4], acc); acc = __builtin_elementwise_fma(__builtin_amdgcn_cvt_pk_f32_fp8(w.z, true), h[5], acc);
    acc = __builtin_elementwise_fma(__builtin_amdgcn_cvt_pk_f32_fp8(w.w, false), h[6], acc); acc = __builtin_elementwise_fma(__builtin_amdgcn_cvt_pk_f32_fp8(w.w, true), h[7], acc);
    return acc.x + acc.y;
}
__device__ __forceinline__ void axpy16_fp8(f32x2 (&o)[8], float a, const v4u w) {
    const f32x2 a2 = {a, a};
    o[0] = __builtin_elementwise_fma(__builtin_amdgcn_cvt_pk_f32_fp8(w.x, false), a2, o[0]); o[1] = __builtin_elementwise_fma(__builtin_amdgcn_cvt_pk_f32_fp8(w.x, true), a2, o[1]);
    o[2] = __builtin_elementwise_fma(__builtin_amdgcn_cvt_pk_f32_fp8(w.y, false), a2, o[2]); o[3] = __builtin_elementwise_fma(__builtin_amdgcn_cvt_pk_f32_fp8(w.y, true), a2, o[3]);
    o[4] = __builtin_elementwise_fma(__builtin_amdgcn_cvt_pk_f32_fp8(w.z, false), a2, o[4]); o[5] = __builtin_elementwise_fma(__builtin_amdgcn_cvt_pk_f32_fp8(w.z, true), a2, o[5]);
    o[6] = __builtin_elementwise_fma(__builtin_amdgcn_cvt_pk_f32_fp8(w.w, false), a2, o[6]); o[7] = __builtin_elementwise_fma(__builtin_amdgcn_cvt_pk_f32_fp8(w.w, true), a2, o[7]);
}
#define SCHED_FENCE() __builtin_amdgcn_sched_barrier(0)
template <bool DRY> __device__ __forceinline__ void peer_gather_wave(int tok0, const bf16* HBp, const unsigned* IDXp, const float* GATEp, const unsigned char* U8, const unsigned char* V8,
                                                 const float* SU, const float* SV, float* Xp, bf16* HBo, const float* prm, bool has_next, int lane) {
    const int hi = lane >> 5;
    const int e_lane = (lane & 7) + 8 * hi;
    const unsigned loff = 16u * (unsigned)lane;
    unsigned idx_lo = IDXp[(size_t)tok0 * NSEL + lane], idx_hi = IDXp[(size_t)tok0 * NSEL + 64 + lane];
    v4u wu[16], wv[16];
#pragma unroll
    for (int e = 0; e < 16; ++e) { const unsigned eid = (unsigned)__builtin_amdgcn_readlane((int)idx_lo, e); wu[e] = *(const v4u*)(U8 + (size_t)eid * D + loff); }
#pragma unroll 1
    for (int t = 0; t < 16; ++t) {
        const int tok = tok0 + t;
        const float su_lo = SU[idx_lo], su_hi = SU[idx_hi], sv_lo = SV[idx_lo], sv_hi = SV[idx_hi];
        unsigned nidx_lo = idx_lo, nidx_hi = idx_hi;
        if (t < 15) { nidx_lo = IDXp[(size_t)(tok + 1) * NSEL + lane]; nidx_hi = IDXp[(size_t)(tok + 1) * NSEL + 64 + lane]; }
        f32x2 h[8];
        { const v4u h0 = *(const v4u*)(HBp + (size_t)tok * D + loff), h1 = *(const v4u*)(HBp + (size_t)tok * D + loff + 8);
          h[0] = (f32x2){bf_lo(h0.x), bf_hi(h0.x)}; h[1] = (f32x2){bf_lo(h0.y), bf_hi(h0.y)}; h[2] = (f32x2){bf_lo(h0.z), bf_hi(h0.z)}; h[3] = (f32x2){bf_lo(h0.w), bf_hi(h0.w)};
          h[4] = (f32x2){bf_lo(h1.x), bf_hi(h1.x)}; h[5] = (f32x2){bf_lo(h1.y), bf_hi(h1.y)}; h[6] = (f32x2){bf_lo(h1.z), bf_hi(h1.z)}; h[7] = (f32x2){bf_lo(h1.w), bf_hi(h1.w)}; }
        float x[16]; load16fB(Xp + (size_t)tok * D, lane, x);
        f32x2 o[8];
#pragma unroll
        for (int i = 0; i < 8; ++i) o[i] = (f32x2){0.f, 0.f};
#pragma unroll 1
        for (int b = 0; b < 8; ++b) {
            const unsigned idxr = (b < 4) ? idx_lo : idx_hi; const int lb = (b & 3) * 16;
#pragma unroll
            for (int e = 0; e < 16; ++e) { const unsigned eid = (unsigned)__builtin_amdgcn_readlane((int)idxr, lb + e); wv[e] = *(const v4u*)(V8 + (size_t)eid * D + loff); }
            const float gt = GATEp[(size_t)tok * NSEL + b * 16 + e_lane];
            SCHED_FENCE();
            float p[16];
#pragma unroll
            for (int e = 0; e < 16; ++e) p[e] = dot16_fp8(wu[e], h);
            SCHED_FENCE();
            { const int nb = (b + 1) & 7; const unsigned nidxr = (b == 7) ? nidx_lo : ((nb < 4) ? idx_lo : idx_hi); const int nlb = (nb & 3) * 16;
#pragma unroll
              for (int e = 0; e < 16; ++e) { const unsigned eid = (unsigned)__builtin_amdgcn_readlane((int)nidxr, nlb + e); wu[e] = *(const v4u*)(U8 + (size_t)eid * D + loff); } }
            SCHED_FENCE();
            float q8[8];
#pragma unroll
            for (int k = 0; k < 8; ++k) { auto r = __builtin_amdgcn_permlane32_swap(__float_as_uint(p[k]), __float_as_uint(p[k + 8]), false, false);
                float v = __uint_as_float(r[0]) + __uint_as_float(r[1]);
                v += dpp_f<0x128>(v); v += dpp_f<0x124>(v); v += dpp_f<0x122>(v); v += dpp_f<0x121>(v);
                q8[k] = v; }
#pragma unroll
            for (int k = 0; k < 8; ++k) q8[k] += __shfl_xor(q8[k], 16);
            const int ks = lane & 7;
            float tot = q8[0];
#pragma unroll
            for (int k = 1; k < 8; ++k) tot = (ks == k) ? q8[k] : tot;
            const float sgu = __shfl((b < 4) ? su_lo : su_hi, lb + e_lane), sgv = __shfl((b < 4) ? sv_lo : sv_hi, lb + e_lane);
            tot *= sgu;
            const float act = 0.5f * tot * (1.f + erff(tot * 0.70710678118654752f)) * gt * sgv;
            SCHED_FENCE();
#pragma unroll
            for (int e = 0; e < 16; ++e) {
                const float a = __uint_as_float((unsigned)__builtin_amdgcn_readlane((int)__float_as_uint(act), (e & 7) + 32 * (e >> 3)));
                axpy16_fp8(o, a, wv[e]);
            }
            SCHED_FENCE();
        }
        float s = 0.f;
#pragma unroll
        for (int i = 0; i < 16; ++i) { const float y = (i & 1) ? o[i >> 1].y : o[i >> 1].x; x[i] = DN_ALPHA * x[i] + prm[loff + i] * y; s += x[i]; }
        const float mean = wave_sum(s) * (1.f / D); float q = 0.f;
#pragma unroll
        for (int i = 0; i < 16; ++i) { x[i] -= mean; q += x[i] * x[i]; }
        const float rstd = 1.f / sqrtf(wave_sum(q) * (1.f / D) + LN_EPS);
#pragma unroll
        for (int i = 0; i < 16; ++i) x[i] = x[i] * rstd * prm[1024 + loff + i] + prm[2048 + loff + i];
        if (DRY) { _Pragma("unroll") for (int i = 0; i < 16; ++i) asm volatile("" :: "v"(x[i])); }
        else store16fB(Xp + (size_t)tok * D, lane, x);
        if (has_next && !DRY) {
#pragma unroll
            for (int i = 0; i < 16; ++i) x[i] = x[i] * (1.f + prm[4096 + loff + i]) + prm[3072 + loff + i];
            store16bfB(HBo + (size_t)tok * D, lane, x);
        }
        idx_lo = nidx_lo; idx_hi = nidx_hi;
    }
}

__device__ __forceinline__ float red8(float v) {
    v += dpp_f<0x141>(v);
    v += dpp_f<0xB1>(v);
    v += dpp_f<0x4E>(v);
    return v;
}
__device__ __forceinline__ void unpack_h16(const v4u h0, const v4u h1, f32x2 (&h)[8]) {
    h[0] = (f32x2){bf_lo(h0.x), bf_hi(h0.x)}; h[1] = (f32x2){bf_lo(h0.y), bf_hi(h0.y)}; h[2] = (f32x2){bf_lo(h0.z), bf_hi(h0.z)}; h[3] = (f32x2){bf_lo(h0.w), bf_hi(h0.w)};
    h[4] = (f32x2){bf_lo(h1.x), bf_hi(h1.x)}; h[5] = (f32x2){bf_lo(h1.y), bf_hi(h1.y)}; h[6] = (f32x2){bf_lo(h1.z), bf_hi(h1.z)}; h[7] = (f32x2){bf_lo(h1.w), bf_hi(h1.w)};
}
__device__ __forceinline__ int red8i(int v) {
    v += __builtin_amdgcn_update_dpp(0, v, 0x141, 0xF, 0xF, true);
    v += __builtin_amdgcn_update_dpp(0, v, 0xB1, 0xF, 0xF, true);
    v += __builtin_amdgcn_update_dpp(0, v, 0x4E, 0xF, 0xF, true);
    return v;
}
__device__ __forceinline__ void peer_pass_u(int x, int t0, int NT, const unsigned char* H8, const unsigned* IDXp, const unsigned char* U8, float* PD, int lane) {
    const int g = lane >> 3, sub = lane & 7; const unsigned coff = 128u * (unsigned)x + 16u * (unsigned)sub;
    const unsigned char* U8s = U8 + (size_t)x * (NEXP * 128) + 16 * sub;
    v4u wuA[16], wuB[16]; v4u hA, hB;
    unsigned ia_lo, ia_hi, ib_lo, ib_hi, ic_lo, ic_hi;
#define PU_META(lo, hi, tok) do { lo = IDXp[(size_t)(tok) * NSEL + lane]; hi = IDXp[(size_t)(tok) * NSEL + 64 + lane]; } while (0)
#define PU_ISSUE(W, H, lo, hi, tok) do { _Pragma("unroll") for (int i = 0; i < 16; ++i) { const unsigned eid = (unsigned)__shfl((int)(i < 8 ? lo : hi), 8 * (i & 7) + g); \
            W[i] = *(const v4u*)(U8s + (size_t)eid * 128); } \
        H = *(const v4u*)(H8 + (size_t)(tok) * D + coff); } while (0)
#define PU_COMPUTE(W, H, tok) do { int vlo = 0, vhi = 0; \
        _Pragma("unroll") for (int i = 0; i < 16; ++i) { int d = __builtin_amdgcn_sdot4((int)W[i].x, (int)H.x, 0, false); d = __builtin_amdgcn_sdot4((int)W[i].y, (int)H.y, d, false); \
            d = __builtin_amdgcn_sdot4((int)W[i].z, (int)H.z, d, false); d = __builtin_amdgcn_sdot4((int)W[i].w, (int)H.w, d, false); \
            const int tot = red8i(d); if (i < 8) vlo = (sub == i) ? tot : vlo; else vhi = (sub == i - 8) ? tot : vhi; } \
        ((unsigned*)PD)[((size_t)x * M + (tok)) * 64 + 8 * sub + g] = pk2((float)vlo, (float)vhi); } while (0)
    PU_META(ia_lo, ia_hi, t0); PU_META(ib_lo, ib_hi, t0 + 1);
    PU_ISSUE(wuA, hA, ia_lo, ia_hi, t0);
#pragma unroll 1
    for (int n = 0; n < NT; n += 2) { const int tok = t0 + n;
        PU_ISSUE(wuB, hB, ib_lo, ib_hi, tok + 1);
        if (n + 2 < NT) PU_META(ic_lo, ic_hi, tok + 2);
        SCHED_FENCE();
        PU_COMPUTE(wuA, hA, tok);
        SCHED_FENCE();
        if (n + 2 < NT) { ia_lo = ic_lo; ia_hi = ic_hi; PU_ISSUE(wuA, hA, ia_lo, ia_hi, tok + 2); PU_META(ic_lo, ic_hi, tok + 3); }
        SCHED_FENCE();
        PU_COMPUTE(wuB, hB, tok + 1);
        SCHED_FENCE();
        ib_lo = ic_lo; ib_hi = ic_hi;
    }
#undef PU_META
#undef PU_ISSUE
#undef PU_COMPUTE
}
__device__ __forceinline__ void peer_pass_a(int t0, int NT, const unsigned* IDXp, float* GATEp, const float* SU, const float* SV, const float* PD, const float* HS, int lane) {
#pragma unroll 1
    for (int n = 0; n < NT; n += 2) {
        float s[2][2], gt[2][2], su[2][2], sv[2][2];
#pragma unroll
        for (int q = 0; q < 2; ++q) { const size_t ro = (size_t)(t0 + n + q) * NSEL;
            const unsigned i0 = IDXp[ro + lane], i1 = IDXp[ro + 64 + lane];
            gt[q][0] = GATEp[ro + lane]; gt[q][1] = GATEp[ro + 64 + lane];
            su[q][0] = SU[i0]; su[q][1] = SU[i1]; sv[q][0] = SV[i0]; sv[q][1] = SV[i1];
            float a0 = 0.f, a1 = 0.f;
#pragma unroll
            for (int xx = 0; xx < 8; ++xx) { const unsigned pw = ((const unsigned*)PD)[((size_t)xx * M + (t0 + n + q)) * 64 + lane]; a0 += bf_lo(pw); a1 += bf_hi(pw); }
            s[q][0] = a0; s[q][1] = a1; }
#pragma unroll
        for (int q = 0; q < 2; ++q) { const size_t ro = (size_t)(t0 + n + q) * NSEL;
            const float hs = HS[t0 + n + q];
#pragma unroll
            for (int k = 0; k < 2; ++k) { const float t = s[q][k] * su[q][k] * hs;
                GATEp[ro + 64 * k + lane] = 0.5f * t * (1.f + erff(t * 0.70710678118654752f)) * gt[q][k] * sv[q][k]; } }
    }
}
__device__ __forceinline__ void peer_pass_v(int x, int t0, int NT, const unsigned* IDXp, const float* Ap, const unsigned char* V8, bf16* YS, int lane) {
    const int g = lane >> 3, sub = lane & 7, hi = lane >> 5; const unsigned coff = 128u * (unsigned)x + 16u * (unsigned)sub;
    const unsigned char* V8s = V8 + (size_t)x * (NEXP * 128) + 16 * sub;
    v4u wvA[16], wvB[16];
    unsigned ia_lo, ia_hi, ib_lo, ib_hi, ic_lo, ic_hi; float aa_lo, aa_hi, ab_lo, ab_hi, ac_lo, ac_hi;
#define PV_META(lo, hi, alo, ahi, tok) do { lo = IDXp[(size_t)(tok) * NSEL + lane]; hi = IDXp[(size_t)(tok) * NSEL + 64 + lane]; alo = Ap[(size_t)(tok) * NSEL + lane]; ahi = Ap[(size_t)(tok) * NSEL + 64 + lane]; } while (0)
#define PV_ISSUE(W, lo, hi) do { _Pragma("unroll") for (int i = 0; i < 16; ++i) { const unsigned eid = (unsigned)__shfl((int)(i < 8 ? lo : hi), 8 * (i & 7) + g); \
            W[i] = *(const v4u*)(V8s + (size_t)eid * 128); } } while (0)
#define PV_COMPUTE(W, alo, ahi, tok) do { float av[16]; _Pragma("unroll") for (int i = 0; i < 16; ++i) av[i] = __shfl(i < 8 ? alo : ahi, 8 * (i & 7) + g); \
        f32x2 o[8]; _Pragma("unroll") for (int i = 0; i < 8; ++i) o[i] = (f32x2){0.f, 0.f}; \
        _Pragma("unroll") for (int i = 0; i < 16; ++i) axpy16_fp8(o, av[i], W[i]); \
        float r8[8]; \
        _Pragma("unroll") for (int c = 0; c < 8; ++c) { const float lo_ = (c & 1) ? o[c >> 1].y : o[c >> 1].x, hh_ = (c & 1) ? o[4 + (c >> 1)].y : o[4 + (c >> 1)].x; \
            auto rr = __builtin_amdgcn_permlane32_swap(__float_as_uint(lo_), __float_as_uint(hh_), false, false); \
            float v = __uint_as_float(rr[0]) + __uint_as_float(rr[1]); v += dpp_f<0x128>(v); r8[c] = v; } \
        _Pragma("unroll") for (int c = 0; c < 8; ++c) r8[c] += __shfl_xor(r8[c], 16); \
        if ((lane & 0x18) == 0) { v4u w; w.x = pk2(r8[0], r8[1]); w.y = pk2(r8[2], r8[3]); w.z = pk2(r8[4], r8[5]); w.w = pk2(r8[6], r8[7]); \
            *(v4u*)(YS + (size_t)(tok) * D + coff + 8 * hi) = w; } } while (0)
    PV_META(ia_lo, ia_hi, aa_lo, aa_hi, t0); PV_META(ib_lo, ib_hi, ab_lo, ab_hi, t0 + 1);
    PV_ISSUE(wvA, ia_lo, ia_hi);
#pragma unroll 1
    for (int n = 0; n < NT; n += 2) { const int tok = t0 + n;
        PV_ISSUE(wvB, ib_lo, ib_hi);
        if (n + 2 < NT) PV_META(ic_lo, ic_hi, ac_lo, ac_hi, tok + 2);
        SCHED_FENCE();
        PV_COMPUTE(wvA, aa_lo, aa_hi, tok);
        SCHED_FENCE();
        if (n + 2 < NT) { ia_lo = ic_lo; ia_hi = ic_hi; aa_lo = ac_lo; aa_hi = ac_hi; PV_ISSUE(wvA, ia_lo, ia_hi); PV_META(ic_lo, ic_hi, ac_lo, ac_hi, tok + 3); }
        SCHED_FENCE();
        PV_COMPUTE(wvB, ab_lo, ab_hi, tok + 1);
        SCHED_FENCE();
        ib_lo = ic_lo; ib_hi = ic_hi; ab_lo = ac_lo; ab_hi = ac_hi;
    }
#undef PV_META
#undef PV_ISSUE
#undef PV_COMPUTE
}

#define KINRAW(k) (((const unsigned long long volatile __attribute__((address_space(4)))*)__builtin_amdgcn_kernarg_segment_ptr())[k])
#define KIN(k) ((const float*)(const GAS float*)KINRAW(k))
__global__ void __launch_bounds__(NTHR, 2) trunk_fwd(Args args) {
    extern __shared__ __attribute__((aligned(16))) unsigned char lds[];
    LAS unsigned char* ldsl = (LAS unsigned char*)lds;
    volatile LAS unsigned* MISC = (volatile LAS unsigned*)(ldsl + MISC_OFF);
    const int G = gridDim.x; const int bx = blockIdx.x; const int vcu = (G % 8 == 0) ? (bx % 8) * (G / 8) + bx / 8 : bx;
    const int NGW = G * NWAVES;
#define PHASE_IDS int tid = threadIdx.x; asm volatile("" : "+v"(tid)); const int lane = tid & 63, wave = __builtin_amdgcn_readfirstlane(tid >> 6); const int gw = vcu * NWAVES + wave; (void)gw; (void)lane;
    gu32* ctl = (gu32*)((GAS unsigned char*)KINRAW(28) + WS_CTL);
    for (int u = threadIdx.x; u < (LDS_BYTES - LDSCTL_OFF) / 4; u += NTHR) ((LAS unsigned*)(ldsl + LDSCTL_OFF))[u] = 0u;
    __syncthreads();
    XcdBarrier bar = xcd_barrier_post((unsigned*)(ctl + CW_BAR), MISC + 8);
#define GRID_BAR() xcd_barrier(bar)

#define x_in KIN(0)
#define c_in KIN(1)
#define ada_mix_w KIN(2)
#define ada_mix_b KIN(3)
#define ln_mix_g KIN(4)
#define ln_mix_b KIN(5)
#define conv_in_w KIN(6)
#define conv_in_b KIN(7)
#define conv_dw_w KIN(8)
#define conv_dw_b KIN(9)
#define conv_ln_g KIN(10)
#define conv_ln_b KIN(11)
#define conv_out_w KIN(12)
#define conv_out_b KIN(13)
#define attn_in_w KIN(14)
#define attn_in_b KIN(15)
#define attn_out_w KIN(16)
#define attn_out_b KIN(17)
#define ada_ffn_w KIN(18)
#define ada_ffn_b KIN(19)
#define ln_ffn_g KIN(20)
#define ln_ffn_b KIN(21)
#define peer_query_w KIN(22)
#define peer_sk1 KIN(23)
#define peer_sk2 KIN(24)
#define peer_u KIN(25)
#define peer_v KIN(26)
#define X ((float*)(GAS float*)KINRAW(27))
#define WSP ((unsigned char*)(GAS unsigned char*)KINRAW(28))
#define MOD ((float*)(WSP + WS_MOD))
#define SKB ((bf16*)(WSP + WS_SKB))
#define LOGF ((float*)(WSP + WS_LOGF))
#define WCI ((bf16*)(WSP + WS_WCI))
#define WCO ((bf16*)(WSP + WS_WCO))
#define WAI ((bf16*)(WSP + WS_WAI))
#define WAO ((bf16*)(WSP + WS_WAO))
#define WPQ ((bf16*)(WSP + WS_WPQ))
#define EXP8 ((unsigned char*)(WSP + WS_EXP))
#define SCL ((float*)(WSP + WS_SC))
#define HB ((bf16*)(WSP + WS_HB))
#define BIG0 ((bf16*)(WSP + WS_BIG))
#define BIG1 ((bf16*)(WSP + WS_BIG + 64 * MiB))
#define BIG2 ((bf16*)(WSP + WS_BIG + 128 * MiB))
#define IDX ((unsigned*)(WSP + WS_IDX))
#define GATE ((float*)(WSP + WS_GATE))
#define HB8 ((unsigned char*)(WSP + WS_HB8))
#define HSC ((float*)(WSP + WS_HS))
#define WCI8 ((unsigned char*)(WSP + WS_WCI8))
#define WAI8 ((unsigned char*)(WSP + WS_WAI8))
#define WPQ8 ((unsigned char*)(WSP + WS_WPQ8))
#define WCO8 ((unsigned char*)(WSP + WS_WCO8))
#define WSC ((float*)(WSP + WS_WSC))

    { PHASE_IDS
        LAS float* scr = (LAS float*)(ldsl + RING_OFF + wave * 16384);
        constexpr int I_CI = 16 * 64, I_CO = 16 * 32, I_AI = 16 * 96, I_AO = 16 * 32, I_PQ = 16 * 64;
        constexpr int NIT = I_CI + I_CO + I_AI + I_AO + 2 * I_PQ;
        for (int it = gw; it < NIT; it += NGW) {
            int r = it;
            if (r < I_CI) { const int kb = r / 64, nb = r % 64, n0 = 32 * nb;
                const int dst = (n0 < 1024) ? (n0 / 128) * 256 + (n0 % 128) : ((n0 - 1024) / 128) * 256 + 128 + ((n0 - 1024) % 128);
                transpose_item(conv_in_w, 1024, 2048, WCI, 64 * kb, n0, dst, scr, lane); continue; } r -= I_CI;
            if (r < I_CO) { const int kb = r / 32, nb = r % 32; transpose_item(conv_out_w, 1024, 1024, WCO, 64 * kb, 32 * nb, 32 * nb, scr, lane); continue; } r -= I_CO;
            if (r < I_AI) { const int kb = r / 96, nb = r % 96; transpose_item(attn_in_w, 1024, NAI, WAI, 64 * kb, 32 * nb, 32 * nb, scr, lane); continue; } r -= I_AI;
            if (r < I_AO) { const int kb = r / 32, nb = r % 32; transpose_item(attn_out_w, 1024, 1024, WAO, 64 * kb, 32 * nb, 32 * nb, scr, lane); continue; } r -= I_AO;
            { const int l = r / I_PQ; r -= l * I_PQ; const int kb = r / 64, nb = r % 64;
              transpose_item(peer_query_w + (size_t)l * 1024 * 2048, 1024, 2048, WPQ + (size_t)l * 2048 * 1024, 64 * kb, 32 * nb, 32 * nb, scr, lane); }
        }
        const int gt = vcu * NTHR + tid, NGT = G * NTHR;
        for (int e = gt; e < 256 * 1024; e += NGT) { const int r = e >> 10, k = e & 1023;
            WAI[(size_t)(3072 + r) * 1024 + k] = (r < 16) ? (bf16)f2bf(attn_in_w[(size_t)k * NAI + 3072 + r]) : (bf16)0; }
        for (int e = gt; e < 2 * 2 * 16384; e += NGT) { const int l = e >> 15, hf = (e >> 14) & 1, i = e & 16383;
            SKB[e] = (bf16)f2bf((hf ? peer_sk2 : peer_sk1)[(size_t)l * 16384 + i]); }
        for (int row0 = gw * 4; row0 < 4 * NEXP; row0 += NGW * 4) {
            float v[4][16];
#pragma unroll
            for (int q = 0; q < 4; ++q) { const int row = row0 + q, t = row >> 14, r = row & (NEXP - 1);
                load16fB(((t & 1) ? peer_v : peer_u) + ((size_t)(t >> 1) * NEXP + r) * D, lane, v[q]); }
#pragma unroll
            for (int q = 0; q < 4; ++q) { const int row = row0 + q;
                float am = 0.f;
#pragma unroll
                for (int i = 0; i < 16; ++i) am = fmaxf(am, fabsf(v[q][i]));
#pragma unroll
                for (int o = 1; o < 64; o <<= 1) am = fmaxf(am, __shfl_xor(am, o));
                const bool isv = ((row >> 14) & 1) != 0;
                const float sc = (am > 0.f) ? am * (isv ? (1.f / 448.f) : (1.f / 127.f)) : 1.f, inv = 1.f / sc;
                v4u w; int pk;
                if (isv) {
                pk = 0; pk = __builtin_amdgcn_cvt_pk_fp8_f32(v[q][0] * inv, v[q][1] * inv, pk, false); pk = __builtin_amdgcn_cvt_pk_fp8_f32(v[q][2] * inv, v[q][3] * inv, pk, true); w.x = (unsigned)pk;
                pk = 0; pk = __builtin_amdgcn_cvt_pk_fp8_f32(v[q][4] * inv, v[q][5] * inv, pk, false); pk = __builtin_amdgcn_cvt_pk_fp8_f32(v[q][6] * inv, v[q][7] * inv, pk, true); w.y = (unsigned)pk;
                pk = 0; pk = __builtin_amdgcn_cvt_pk_fp8_f32(v[q][8] * inv, v[q][9] * inv, pk, false); pk = __builtin_amdgcn_cvt_pk_fp8_f32(v[q][10] * inv, v[q][11] * inv, pk, true); w.z = (unsigned)pk;
                pk = 0; pk = __builtin_amdgcn_cvt_pk_fp8_f32(v[q][12] * inv, v[q][13] * inv, pk, false); pk = __builtin_amdgcn_cvt_pk_fp8_f32(v[q][14] * inv, v[q][15] * inv, pk, true); w.w = (unsigned)pk;
                } else {
                w.x = pack_i8x4(v[q][0] * inv, v[q][1] * inv, v[q][2] * inv, v[q][3] * inv); w.y = pack_i8x4(v[q][4] * inv, v[q][5] * inv, v[q][6] * inv, v[q][7] * inv);
                w.z = pack_i8x4(v[q][8] * inv, v[q][9] * inv, v[q][10] * inv, v[q][11] * inv); w.w = pack_i8x4(v[q][12] * inv, v[q][13] * inv, v[q][14] * inv, v[q][15] * inv);
                }
                *(v4u*)(EXP8 + (size_t)(row >> 14) * NEXP * D + (size_t)(lane >> 3) * (NEXP * 128) + (size_t)(row & (NEXP - 1)) * 128 + 16 * (lane & 7)) = w;
                if (lane == 0) SCL[row] = sc; } }
        for (int it = bx; it < 4 * 6 * 32; it += G) { const int s = it / 192, rem = it % 192, jb = rem / 32, ksp = rem % 32; const int j = jb * 512 + tid;
            const float* W = ((s & 1) ? ada_ffn_w : ada_mix_w) + (size_t)(s >> 1) * 1024 * 3072; const float* bs = ((s & 1) ? ada_ffn_b : ada_mix_b) + (s >> 1) * 3072;
            float a[8];
#pragma unroll
            for (int b = 0; b < 8; ++b) a[b] = 0.f;
            for (int k = ksp * 32; k < ksp * 32 + 32; ++k) { const float w = W[(size_t)k * 3072 + j];
#pragma unroll
                for (int b = 0; b < 8; ++b) { const float cv = c_in[b * 1024 + k]; a[b] += (cv / (1.f + __expf(-cv))) * w; } }
            const float bj = (ksp == 0) ? bs[j] : 0.f;
#pragma unroll
            for (int b = 0; b < 8; ++b) atomicAdd(MOD + ((size_t)s * 8 + b) * 3072 + j, a[b] + bj); }
    }
    GRID_BAR();
    { PHASE_IDS
      const float* mod = MOD + (size_t)(0 * 8 + ((gw * 16) >> 12)) * 3072;
      float sc1[16], sh[16]; load16f(mod + 1024, lane, sc1); load16f(mod, lane, sh);
      float xn[16]; load16f(x_in + (size_t)(gw * 16) * D, lane, xn);
      for (int r = 0; r < 16; ++r) { const int m = gw * 16 + r;
        float x[16];
#pragma unroll
        for (int i = 0; i < 16; ++i) x[i] = xn[i];
        if (r < 15) load16f(x_in + (size_t)(m + 1) * D, lane, xn);
#pragma unroll
        for (int i = 0; i < 16; ++i) x[i] = x[i] * (1.f + sc1[i]) + sh[i];
        store_row_i8(x, HB8 + (size_t)m * D, HSC + m, lane); }
      for (int row = gw; row < 2048 + NAI_PAD + 4096 + 1024; row += NGW) { const bool ci = row < 2048, co = row >= 2048 + NAI_PAD + 4096, pq = !co && row >= 2048 + NAI_PAD;
          const int r = ci ? row : (co ? row - 2048 - NAI_PAD - 4096 : (pq ? row - 2048 - NAI_PAD : row - 2048));
          const bf16* src = (ci ? WCI : (co ? WCO : (pq ? WPQ : WAI))) + (size_t)r * D + 16 * lane;
          const v4u a0 = *(const v4u*)src, a1 = *(const v4u*)(src + 8);
          float v[16];
          v[0] = bf_lo(a0.x); v[1] = bf_hi(a0.x); v[2] = bf_lo(a0.y); v[3] = bf_hi(a0.y); v[4] = bf_lo(a0.z); v[5] = bf_hi(a0.z); v[6] = bf_lo(a0.w); v[7] = bf_hi(a0.w);
          v[8] = bf_lo(a1.x); v[9] = bf_hi(a1.x); v[10] = bf_lo(a1.y); v[11] = bf_hi(a1.y); v[12] = bf_lo(a1.z); v[13] = bf_hi(a1.z); v[14] = bf_lo(a1.w); v[15] = bf_hi(a1.w);
          float am = 0.f;
#pragma unroll
          for (int i = 0; i < 16; ++i) am = fmaxf(am, fabsf(v[i]));
          am = wave_max_nl(am);
          const float sc = (am > 0.f) ? am * (1.f / 127.f) : 1.f, inv = 1.f / sc;
          v4u w; w.x = pack_i8x4(v[0] * inv, v[1] * inv, v[2] * inv, v[3] * inv); w.y = pack_i8x4(v[4] * inv, v[5] * inv, v[6] * inv, v[7] * inv);
          w.z = pack_i8x4(v[8] * inv, v[9] * inv, v[10] * inv, v[11] * inv); w.w = pack_i8x4(v[12] * inv, v[13] * inv, v[14] * inv, v[15] * inv);
          *(v4u*)((ci ? WCI8 : (co ? WCO8 : (pq ? WPQ8 : WAI8))) + (size_t)r * D + 16 * lane) = w;
          if (lane == 0) WSC[row] = sc; } }
    GRID_BAR();

    if (PHM & 1) { pg8::Gemm g{(const bf16*)HB8, (const bf16*)WCI8, M, 2048, D / 2}; pg8::StaticOrder S; S.init(M, 2048, G, bx);
      pg8::EpiGluI8 E{BIG0, conv_in_b, HSC, WSC};
      for (int rep_ = 0; rep_ < NREP_GEMM; ++rep_) {
      pg8::gemm_phase<pg8::EpiGluI8, pg8::StaticOrder, PG8_ALIGN, PG8_SP2, true>(ldsl + RING_OFF, g, S, E); } }
    GRID_BAR();
    if (PHM & 2) { PHASE_IDS
        constexpr int TT = 16;
        float* red = (float*)(lds + RING_OFF);
        float* stats = red + 8 * 2 * TT;
        const int c = 2 * tid;
        const float bd0 = conv_dw_b[c], bd1 = conv_dw_b[c + 1], lg0 = conv_ln_g[c], lg1 = conv_ln_g[c + 1], lb0 = conv_ln_b[c], lb1 = conv_ln_b[c + 1];
        const float* wdw = conv_dw_w + c;
        float cw0[31], cw1[31];
#pragma unroll
        for (int w = 0; w < 31; ++w) { cw0[w] = wdw[w * D]; cw1[w] = wdw[w * D + 1]; }
        unsigned in[TT + 30];
        for (int kt = 0; kt < (M / TT) / 256; ++kt) { const int tile = vcu * ((M / TT) / 256) + kt;
            const int t0 = tile * TT, pos0 = t0 & (SEQ - 1);
            if (kt == 0) {
#pragma unroll
                for (int j = 0; j < 30; ++j) in[j] = (pos0 + j >= 30) ? *(const unsigned*)(BIG0 + (size_t)(t0 - 30 + j) * D + c) : 0u;
            } else {
#pragma unroll
                for (int j = 0; j < 30; ++j) in[j] = in[j + TT];
            }
#pragma unroll
            for (int j = 30; j < TT + 30; ++j) in[j] = *(const unsigned*)(BIG0 + (size_t)(t0 - 30 + j) * D + c);
            float o0[TT], o1[TT];
            {
                f32x2 op[TT];
#pragma unroll
                for (int i = 0; i < TT; ++i) op[i] = (f32x2){bd0, bd1};
#pragma unroll
                for (int w = 0; w < 31; ++w) { const f32x2 cw = {cw0[w], cw1[w]};
#pragma unroll
                    for (int i = 0; i < TT; ++i) { const f32x2 xv = {bf_lo(in[i + w]), bf_hi(in[i + w])}; op[i] = __builtin_elementwise_fma(xv, cw, op[i]); } }
#pragma unroll
                for (int i = 0; i < TT; ++i) { o0[i] = op[i].x; o1[i] = op[i].y; }
            }
            { float rv[2 * TT];
#pragma unroll
              for (int i = 0; i < TT; ++i) { rv[2 * i] = o0[i] + o1[i]; rv[2 * i + 1] = o0[i] * o0[i] + o1[i] * o1[i]; }
              const int hi5 = lane >> 5;
              float r16[TT];
#pragma unroll
              for (int k = 0; k < TT; ++k) { auto rr = __builtin_amdgcn_permlane32_swap(__float_as_uint(rv[k]), __float_as_uint(rv[k + TT]), false, false);
                  float v = __uint_as_float(rr[0]) + __uint_as_float(rr[1]);
                  v += dpp_f<0x128>(v); v += dpp_f<0x124>(v); v += dpp_f<0x122>(v); v += dpp_f<0x121>(v);
                  r16[k] = v; }
#pragma unroll
              for (int k = 0; k < TT; ++k) r16[k] += __uint_as_float((unsigned)__builtin_amdgcn_ds_swizzle((int)__float_as_uint(r16[k]), 0x401F));
              float mine = r16[0];
#pragma unroll
              for (int k = 1; k < TT; ++k) mine = ((lane & 15) == k) ? r16[k] : mine;
              if ((lane & 16) == 0) red[wave * 2 * TT + (lane & 15) + 16 * hi5] = mine; }
            __syncthreads();
            if (tid < 2 * TT) { float a = 0.f;
#pragma unroll
                for (int w = 0; w < 8; ++w) a += red[w * 2 * TT + tid];
                stats[tid] = a; }
            __syncthreads();
#pragma unroll
            for (int i = 0; i < TT; ++i) { const float mean = stats[2 * i] * (1.f / D); const float var = fmaxf(stats[2 * i + 1] * (1.f / D) - mean * mean, 0.f);
                const float rstd = 1.f / sqrtf(var + LN_EPS);
                float y0 = (o0[i] - mean) * rstd * lg0 + lb0, y1 = (o1[i] - mean) * rstd * lg1 + lb1;
                y0 = y0 / (1.f + __expf(-y0)); y1 = y1 / (1.f + __expf(-y1));
                o0[i] = y0; o1[i] = y1;
                const float wm = wave_max_nl(fmaxf(fabsf(y0), fabsf(y1)));
                if (lane == 0) red[wave * TT + i] = wm; }
            __syncthreads();
            if (tid < TT) { float a = 0.f;
#pragma unroll
                for (int w = 0; w < 8; ++w) a = fmaxf(a, red[w * TT + tid]);
                const float sc = (a > 0.f) ? a * (1.f / 127.f) : 1.f;
                stats[tid] = sc; HSC[t0 + tid] = sc; }
            __syncthreads();
#pragma unroll
            for (int i = 0; i < TT; ++i) { const float inv = 1.f / stats[i];
                int q0 = __float2int_rn(o0[i] * inv), q1 = __float2int_rn(o1[i] * inv); q0 = max(-127, min(127, q0)); q1 = max(-127, min(127, q1));
                *(unsigned short*)((unsigned char*)BIG1 + (size_t)(t0 + i) * D + c) = (unsigned short)(((unsigned)q0 & 255u) | (((unsigned)q1 & 255u) << 8)); }
            __syncthreads();
        }
    }
    GRID_BAR();
    { pg8::Gemm g{(const bf16*)BIG1, (const bf16*)WCO8, M, D, D / 2}; pg8::StaticOrder S; S.init(M, D, G, bx);
      pg8::EpiBf16I8 E{BIG2, D, conv_out_b, 0, 0, 1.f, HSC, WSC + 2048 + NAI_PAD + 4096};
      for (int rep_ = 0; rep_ < NREP_GEMM; ++rep_) {
      pg8::gemm_phase<pg8::EpiBf16I8, pg8::StaticOrder, PG8_ALIGN, PG8_SP2, true>(ldsl + RING_OFF, g, S, E); } }
    GRID_BAR();

    for (int layer = 0; layer < 2; ++layer) {
        if (layer == 1) {
            { pg8::Gemm g{(const bf16*)HB8, (const bf16*)WAI8, M, NAI_PAD, D / 2}; pg8::StaticOrder S; S.init(M, NAI_PAD, G, bx);
              pg8::EpiQkvfI8 E{pg8::EpiBf16I8{BIG0, D, attn_in_b, D, (size_t)(64 * MiB) / 2, attn_body::C2, HSC, WSC + 2048}, LOGF, attn_in_b};
              for (int rep_ = 0; rep_ < NREP_GEMM; ++rep_) {
              pg8::gemm_phase<pg8::EpiQkvfI8, pg8::StaticOrder, PG8_ALIGN, PG8_SP2, true>(ldsl + RING_OFF, g, S, E); } }
            GRID_BAR();
            if (PHM & 4) { PHASE_IDS
                float* kb = (float*)(lds + KB_OFF); float* wsum = (float*)(lds + KB_OFF + 16384);
                const int bh = vcu >> 1;
                const float* lf = LOGF + (size_t)bh * SEQ + 8 * tid;
                const f32x4 a = *(const f32x4*)lf, b = *(const f32x4*)(lf + 4);
                float p[8]; p[0] = a[0]; p[1] = p[0] + a[1]; p[2] = p[1] + a[2]; p[3] = p[2] + a[3]; p[4] = p[3] + b[0]; p[5] = p[4] + b[1]; p[6] = p[5] + b[2]; p[7] = p[6] + b[3];
                float incl = p[7];
#pragma unroll
                for (int o = 1; o < 64; o <<= 1) { const float t = __uint_as_float((unsigned)__builtin_amdgcn_ds_bpermute((lane - o) << 2, (int)__float_as_uint(incl))); if (lane >= o) incl += t; }
                if (lane == 63) wsum[wave] = incl;
                __syncthreads();
                float base = incl - p[7];
                for (int w = 0; w < wave; ++w) base += wsum[w];
#pragma unroll
                for (int i = 0; i < 8; ++i) kb[8 * tid + i] = -(base + p[i]) * 1.4426950408889634f;
                __syncthreads();
                const attn_body::AttnTensors AT{(const attn_body::bf16*)BIG0, (const attn_body::bf16*)BIG1, (const attn_body::bf16*)BIG2, (attn_body::bf16*)HB};
                const attn_body::StaticOrder S(G, bx);
                for (int rep_ = 0; rep_ < NREP_ATTN; ++rep_) attn_body::attn_phase<attn_body::StaticOrder, 100>((char*)lds + RING_OFF, AT, S, (attn_body::lds_fptr)(ldsl + KB_OFF));
            }
            GRID_BAR();
            { pg8::Gemm g{HB, WAO, M, D, D}; pg8::StaticOrder S; S.init(M, D, G, bx);
              pg8::EpiBf16<0> E{BIG1, D, attn_out_b, 0, 0, 1.f};
              for (int rep_ = 0; rep_ < NREP_GEMM; ++rep_) {
      pg8::gemm_phase<pg8::EpiBf16<0>, pg8::StaticOrder, PG8_ALIGN, PG8_SP2>(ldsl + RING_OFF, g, S, E); } }
            GRID_BAR();
        }
        { PHASE_IDS
            const bf16* Y = (layer == 0) ? BIG2 : BIG1; const float* xin = (layer == 0) ? x_in : X;
            const int smix = 2 * layer, sffn = 2 * layer + 1;
            const int b = (gw * 16) >> 12;
            float xn[16]; load16f(xin + (size_t)(gw * 16) * D, lane, xn);
            v4u y0n = *(const v4u*)(Y + (size_t)(gw * 16) * D + 8 * lane), y1n = *(const v4u*)(Y + (size_t)(gw * 16) * D + 512 + 8 * lane);
            for (int r = 0; r < 16; ++r) { const int m = gw * 16 + r;
                float x[16]; const v4u y0 = y0n, y1 = y1n;
#pragma unroll
                for (int i = 0; i < 16; ++i) x[i] = xn[i];
                if (r < 15) { load16f(xin + (size_t)(m + 1) * D, lane, xn); y0n = *(const v4u*)(Y + (size_t)(m + 1) * D + 8 * lane); y1n = *(const v4u*)(Y + (size_t)(m + 1) * D + 512 + 8 * lane); }
                float y[16];
                y[0] = bf_lo(y0.x); y[1] = bf_hi(y0.x); y[2] = bf_lo(y0.y); y[3] = bf_hi(y0.y); y[4] = bf_lo(y0.z); y[5] = bf_hi(y0.z); y[6] = bf_lo(y0.w); y[7] = bf_hi(y0.w);
                y[8] = bf_lo(y1.x); y[9] = bf_hi(y1.x); y[10] = bf_lo(y1.y); y[11] = bf_hi(y1.y); y[12] = bf_lo(y1.z); y[13] = bf_hi(y1.z); y[14] = bf_lo(y1.w); y[15] = bf_hi(y1.w);
                resid_ln_row_pre(x, y, MOD + (size_t)(smix * 8 + b) * 3072 + 2048, ln_mix_g + layer * D, ln_mix_b + layer * D,
                                 X + (size_t)m * D, HB + (size_t)m * D, MOD + (size_t)(sffn * 8 + b) * 3072, lane, HB8 + (size_t)m * D, HSC + m, false); }
        }
        GRID_BAR();
        { pg8::Gemm g{(const bf16*)HB8, (const bf16*)(WPQ8 + (size_t)layer * 2048 * 1024), M, 2048, D / 2}; pg8::StaticOrder S; S.init(M, 2048, G, bx);
          pg8::EpiPqI8 E{BIG0, HSC, WSC + 2048 + NAI_PAD + layer * 2048};
          for (int rep_ = 0; rep_ < NREP_GEMM; ++rep_) {
          pg8::gemm_phase<pg8::EpiPqI8, pg8::StaticOrder, PG8_ALIGN, PG8_SP2, true>(ldsl + RING_OFF, g, S, E); } }
        GRID_BAR();
        if (PHM & 8) { PHASE_IDS
            LAS bf16x8* skf = (LAS bf16x8*)(ldsl + RING_OFF);
            { const bf16* SK = SKB + (size_t)layer * 2 * 16384;
              for (int f = tid; f < 4096; f += NTHR) { const int ln = f & 63, ks = (f >> 6) & 7, kb = (f >> 9) & 3, hf = f >> 11;
                  skf[f] = *(const bf16x8*)(SK + hf * 16384 + (kb * 32 + (ln & 31)) * 128 + ks * 16 + (ln >> 5) * 8); } }
            __syncthreads();
            for (int rep_ = 0; rep_ < NREP_TOPK; ++rep_) for (int it = gw; it < (M / 32) * 8; it += NGW) peer_topk_item(BIG0, skf, IDX, GATE, it >> 3, it & 7, lane); }
        GRID_BAR();
        if (PHM & 16) {
            const int xs = bx & 7, jb = bx >> 3;
            { PHASE_IDS
              for (int rep_ = 0; rep_ < NREP_PU; ++rep_)
              peer_pass_u(xs, jb * 1024 + wave * 128, 128, HB8, IDX, EXP8 + (size_t)(2 * layer) * NEXP * D, (float*)BIG0, lane); }
            GRID_BAR();
            { PHASE_IDS
              peer_pass_a(gw * 16, 16, IDX, GATE, SCL + (size_t)(2 * layer) * NEXP, SCL + (size_t)(2 * layer + 1) * NEXP, (const float*)BIG0, HSC, lane); }
            GRID_BAR();
            { PHASE_IDS
              for (int rep_ = 0; rep_ < NREP_PV; ++rep_)
              peer_pass_v(xs, jb * 1024 + wave * 128, 128, IDX, GATE, EXP8 + (size_t)(2 * layer + 1) * NEXP * D, BIG2, lane); }
            GRID_BAR();
            { PHASE_IDS
              const int sffn = 2 * layer + 1; const int b = (gw * 16) >> 12; const bf16* Y = BIG2;
              float xn[16]; load16f(X + (size_t)(gw * 16) * D, lane, xn);
              v4u y0n = *(const v4u*)(Y + (size_t)(gw * 16) * D + 8 * lane), y1n = *(const v4u*)(Y + (size_t)(gw * 16) * D + 512 + 8 * lane);
              for (int r = 0; r < 16; ++r) { const int m = gw * 16 + r;
                float x[16]; const v4u y0 = y0n, y1 = y1n;
#pragma unroll
                for (int i = 0; i < 16; ++i) x[i] = xn[i];
                if (r < 15) { load16f(X + (size_t)(m + 1) * D, lane, xn); y0n = *(const v4u*)(Y + (size_t)(m + 1) * D + 8 * lane); y1n = *(const v4u*)(Y + (size_t)(m + 1) * D + 512 + 8 * lane); }
                float y[16];
                y[0] = bf_lo(y0.x); y[1] = bf_hi(y0.x); y[2] = bf_lo(y0.y); y[3] = bf_hi(y0.y); y[4] = bf_lo(y0.z); y[5] = bf_hi(y0.z); y[6] = bf_lo(y0.w); y[7] = bf_hi(y0.w);
                y[8] = bf_lo(y1.x); y[9] = bf_hi(y1.x); y[10] = bf_lo(y1.y); y[11] = bf_hi(y1.y); y[12] = bf_lo(y1.z); y[13] = bf_hi(y1.z); y[14] = bf_lo(y1.w); y[15] = bf_hi(y1.w);
                resid_ln_row_pre(x, y, MOD + (size_t)(sffn * 8 + b) * 3072 + 2048, ln_ffn_g + layer * D, ln_ffn_b + layer * D,
                                 X + (size_t)m * D, HB + (size_t)m * D, (layer == 0) ? MOD + (size_t)(2 * 8 + b) * 3072 : nullptr, lane, HB8 + (size_t)m * D, HSC + m, false); } }
        }
        if (layer == 0) GRID_BAR();
    }
}

extern "C" void kernel_launch(void* const* d_in, const int* in_sizes, int n_in, void* d_out, int out_size, void* d_ws, size_t ws_size, hipStream_t stream) {
    static int grid = 0;
    if (grid == 0) {
        if (n_in != 27 || in_sizes[0] != M * D || out_size != M * D || ws_size < WS_END) { fprintf(stderr, "kernel_launch: unexpected shapes (n_in %d, in0 %d, out %d, ws %zu); nothing launched\n", n_in, n_in > 0 ? in_sizes[0] : -1, out_size, ws_size); grid = -1; return; }
        int dev = 0, cus = 0, per_cu = 0;
        if (hipGetDevice(&dev) != hipSuccess || hipDeviceGetAttribute(&cus, hipDeviceAttributeMultiprocessorCount, dev) != hipSuccess) { grid = -1; return; }
        if (hipFuncSetAttribute((const void*)trunk_fwd, hipFuncAttributeMaxDynamicSharedMemorySize, LDS_BYTES) != hipSuccess) { fprintf(stderr, "kernel_launch: hipFuncSetAttribute failed\n"); grid = -1; return; }
        if (hipOccupancyMaxActiveBlocksPerMultiprocessor(&per_cu, (const void*)trunk_fwd, NTHR, LDS_BYTES) != hipSuccess || per_cu < 1) { fprintf(stderr, "kernel_launch: occupancy query reports %d blocks per CU\n", per_cu); }
        (void)hipGetLastError();
        grid = cus;
        if (grid != 256) fprintf(stderr, "kernel_launch: %d CUs; this build expects 256\n", grid);
    }
    if (grid < 0) return;
    if (hipMemsetAsync((char*)d_ws + WS_CTL, 0, CTL_ZERO_BYTES, stream) != hipSuccess) return;
    Args a{};
    for (int i = 0; i < 27; ++i) a.in[i] = (const float*)d_in[i];
    a.out = (float*)d_out; a.ws = (unsigned char*)d_ws;
    hipLaunchKernelGGL(trunk_fwd, dim3(grid), dim3(NTHR), LDS_BYTES, stream, a);
}
```

```cpp
#include <hip/hip_runtime.h>
#include <cstdio>
#include <cstdint>
namespace pg8 {
#define PG8_LAS __attribute__((address_space(3)))
typedef unsigned short bf16_t;
typedef short bf16x8 __attribute__((ext_vector_type(8)));
typedef float f32x4 __attribute__((ext_vector_type(4)));
typedef unsigned u32x4 __attribute__((ext_vector_type(4)));
constexpr int BM = 256, BK = 64, HALF = 128, HTB = HALF * BK * 2  , STAGE_BYTES = 8 * HTB, NXCD = 8, WGM = 8;

__host__ __device__ __forceinline__ int lds_byte(int r, int c) { const int st = (r >> 4) * 2 + (c >> 5), rr = r & 15, cc = c & 31, ob = rr * 64 + cc * 2; return st * 1024 + (ob ^ (((ob >> 9) & 1) << 5)); }
__host__ __device__ __forceinline__ void stage_rc(int b, int& R, int& C) { const int st = b / 1024, sb = b % 1024, swz = sb ^ (((sb >> 9) & 1) << 5); R = (st >> 1) * 16 + swz / 64; C = (st & 1) * 32 + (swz % 64) / 2; }
__host__ __device__ __forceinline__ int perm32(int rho) { const int n = rho >> 4, i = rho & 15; return 8 * (i >> 2) + 4 * n + (i & 3); }

struct Unit { int pm, pn; };
struct Gemm { const bf16_t* A; const bf16_t* Bt; int M, N, K; };

struct StaticOrder {
    int nM, nN, nwg, G, c;
    __host__ __device__ void init(int M, int N, int G_, int c_) { nM = M / BM; nN = N / BM; nwg = nM * nN; G = G_; c = c_; }
    __host__ __device__ bool next(int i, Unit& u) const {
        const long L = (long)i * G + c; if (L >= nwg) return false;
        int wgid = (int)L; { const int q = nwg / NXCD, r = nwg % NXCD, xcd = wgid % NXCD, off = wgid / NXCD; wgid = (xcd < r ? xcd * (q + 1) : r * (q + 1) + (xcd - r) * q) + off; }
        const int nig = WGM * nN, gid = wgid / nig, fm = gid * WGM, gsz = (nM - fm) < WGM ? (nM - fm) : WGM;
        u.pm = fm + ((wgid % nig) % gsz); u.pn = (wgid % nig) / gsz; return true;
    }
    __device__ __forceinline__ void a_ready(const Unit&) const {}
    __device__ __forceinline__ void done(const Unit&) const {}
};

__device__ __forceinline__ unsigned cvt_pk_bf16(float lo, float hi) { unsigned r; asm volatile("v_cvt_pk_bf16_f32 %0, %1, %2" : "=v"(r) : "v"(lo), "v"(hi)); return r; }
typedef float f32x2 __attribute__((ext_vector_type(2)));
__device__ __forceinline__ f32x2 gelu_pk(f32x2 v) {
    const f32x2 av = __builtin_elementwise_abs(v), d = av * 0.2316418882f + 1.0f;
    f32x2 t; t.x = __builtin_amdgcn_rcpf(d.x); t.y = __builtin_amdgcn_rcpf(d.y);
    f32x2 q = t * 0.5307027145f + (-0.7265760135f); q = q * t + 0.7107068705f; q = q * t + (-0.142248368f); q = q * t + 0.127414796f; q = q * t;
    const f32x2 s = (v * v) * (-0.72134752044f);
    f32x2 e; e.x = __builtin_amdgcn_exp2f(s.x); e.y = __builtin_amdgcn_exp2f(s.y);
    const f32x2 m = v * (q * e), r = v - m;
    f32x2 o; o.x = v.x < 0.f ? m.x : r.x; o.y = v.y < 0.f ? m.y : r.y; return o;
}

template <int ACT  > struct EpiBf16 {
    static constexpr bool PERM = true, AFTER_DRAIN = false; static_assert(ACT == 0 || ACT == 1, "EpiBf16: ACT is 0 (none) or 1 (gelu_pk)");
    bf16_t* O; int ldc; const float* bias; int split_cols; size_t split_stride; float scale0;
    __device__ __forceinline__ void operator()(const f32x4 (&acc)[2][2][4][2], const Unit& u, int wr, int wc, int fr, int fq) const {
        const int row0 = u.pm * BM + wr * 64 + fr; int colt = u.pn * BM; bf16_t* base = O;
        float sc = 1.f; if (split_cols) { const int t = colt / split_cols; base += (size_t)t * split_stride; colt -= t * split_cols; if (t == 0) sc = scale0; }
        const int col0 = colt + wc * 32 + 8 * fq, bcol0 = u.pn * BM + wc * 32 + 8 * fq;
        f32x4 bv[2][2];
#pragma unroll
        for (int bj = 0; bj < 2; ++bj)
#pragma unroll
            for (int n = 0; n < 2; ++n) bv[bj][n] = bias ? *(const f32x4*)(bias + bcol0 + bj * HALF + 4 * n) : (f32x4){0.f, 0.f, 0.f, 0.f};
#pragma unroll
        for (int ai = 0; ai < 2; ++ai)
#pragma unroll
            for (int m = 0; m < 4; ++m) { bf16_t* rowp = base + (size_t)(row0 + ai * HALF + m * 16) * ldc + col0;
#pragma unroll
                for (int bj = 0; bj < 2; ++bj) { f32x4 v0 = acc[ai][bj][m][0] + bv[bj][0], v1 = acc[ai][bj][m][1] + bv[bj][1];
                    if (ACT == 1) { f32x2 a = gelu_pk((f32x2){v0[0], v0[1]}), b = gelu_pk((f32x2){v0[2], v0[3]}), c = gelu_pk((f32x2){v1[0], v1[1]}), d = gelu_pk((f32x2){v1[2], v1[3]});
                        v0 = (f32x4){a.x, a.y, b.x, b.y}; v1 = (f32x4){c.x, c.y, d.x, d.y}; }
                    v0 = v0 * sc; v1 = v1 * sc; u32x4 w; w.x = cvt_pk_bf16(v0[0], v0[1]); w.y = cvt_pk_bf16(v0[2], v0[3]); w.z = cvt_pk_bf16(v1[0], v1[1]); w.w = cvt_pk_bf16(v1[2], v1[3]);
                    *(u32x4*)(rowp + bj * HALF) = w; } }
    }
};
template <bool I8> __device__ __forceinline__ f32x4 mma16(const bf16x8 a, const bf16x8 b, const f32x4 c) {
    if constexpr (I8) { typedef int v4i_t __attribute__((ext_vector_type(4)));
        return __builtin_bit_cast(f32x4, __builtin_amdgcn_mfma_i32_16x16x64_i8(__builtin_bit_cast(v4i_t, a), __builtin_bit_cast(v4i_t, b), __builtin_bit_cast(v4i_t, c), 0, 0, 0)); }
    else return __builtin_amdgcn_mfma_f32_16x16x32_bf16(a, b, c, 0, 0, 0);
}
template <class Epi, class Sched, bool ALIGN_EPI = false, bool SP2 = false, bool I8 = false>
__device__ __forceinline__ void gemm_phase(PG8_LAS unsigned char* lds, const Gemm g, const Sched& S, const Epi& E) {
    int tid = threadIdx.x; asm volatile("" : "+v"(tid)); const int wid = __builtin_amdgcn_readfirstlane(tid >> 6), lane = tid & 63, wr = wid >> 2, wc = wid & 3, fr = lane & 15, fq = lane >> 4;
    const int K = g.K, nt = K / BK;
    unsigned voffA[2], voffB[2];
#pragma unroll
    for (int i = 0; i < 2; ++i) { int R, C; stage_rc(tid * 16 + i * 8192, R, C); const int Rb = Epi::PERM ? ((R & ~31) + perm32(R & 31)) : R;
        voffA[i] = (unsigned)(R * K + C) * 2u; voffB[i] = (unsigned)(Rb * K + C) * 2u; }
    const size_t kstep = (size_t)(BK * 2);
    const size_t hstep = (size_t)HALF * K * 2;
    const size_t tstep = 2 * hstep;
    const unsigned ldsw = (unsigned)wid * 1024u;
    const int aoff = lds_byte(wr * 64 + fr, fq * 8), boff = lds_byte(wc * 32 + fr, fq * 8);
#define PG8_SA(b, h) (((b) * 2 + (h)) * HTB)
#define PG8_SB(b, h) ((4 + (b) * 2 + (h)) * HTB)
#define PG8_STAGE(bufoff, gbase, voff) do { _Pragma("unroll") for (int _i = 0; _i < 2; ++_i) \
        __builtin_amdgcn_global_load_lds((const unsigned*)((const char*)(gbase) + (voff)[_i]), (PG8_LAS unsigned*)(lds + (bufoff) + ldsw + _i * 8192), 16, 0, 0); } while (0)
#define PG8_LDA(dst, b, h) do { _Pragma("unroll") for (int m = 0; m < 4; ++m) _Pragma("unroll") for (int k = 0; k < 2; ++k) dst[m][k] = *(const PG8_LAS bf16x8*)(lds + PG8_SA(b, h) + aoff + m * 2048 + k * 1024); } while (0)
#define PG8_LDB(dst, b, h) do { _Pragma("unroll") for (int n = 0; n < 2; ++n) _Pragma("unroll") for (int k = 0; k < 2; ++k) dst[n][k] = *(const PG8_LAS bf16x8*)(lds + PG8_SB(b, h) + boff + n * 2048 + k * 1024); } while (0)
#define PG8_MMA(ai, bj, At, Bt) do { __builtin_amdgcn_s_setprio(1); _Pragma("unroll") for (int m = 0; m < 4; ++m) _Pragma("unroll") for (int n = 0; n < 2; ++n) _Pragma("unroll") for (int k = 0; k < 2; ++k) \
        acc[ai][bj][m][n] = mma16<I8>(Bt[n][k], At[m][k], acc[ai][bj][m][n]); __builtin_amdgcn_s_setprio(0); } while (0)
#define PG8_WAIT_V(n) asm volatile("s_waitcnt vmcnt(" #n ")" ::: "memory")
#define PG8_WAIT_L(n) asm volatile("s_waitcnt lgkmcnt(" #n ")" ::: "memory")
#define PG8_BAR __builtin_amdgcn_s_barrier()
#define PG8_SCHED __builtin_amdgcn_sched_barrier(0)
    Unit cur, nxt; int ui = 0;
    if (!S.next(0, cur)) return;
    f32x4 acc[2][2][4][2];
#pragma unroll
    for (int a = 0; a < 2; ++a)
#pragma unroll
        for (int b = 0; b < 2; ++b)
#pragma unroll
            for (int m = 0; m < 4; ++m)
#pragma unroll
                for (int n = 0; n < 2; ++n) acc[a][b][m][n] = (f32x4){0.f, 0.f, 0.f, 0.f};
    bf16x8 At[4][2], B0[2][2], B1[2][2];
    const char* cA = (const char*)g.A + (size_t)cur.pm * tstep; const char* cB = (const char*)g.Bt + (size_t)cur.pn * tstep;
    S.a_ready(cur);
    if constexpr (SP2) {
        PG8_STAGE(PG8_SB(0, 0), cB, voffB); PG8_STAGE(PG8_SB(0, 1), cB + hstep, voffB); PG8_STAGE(PG8_SA(0, 0), cA, voffA); PG8_STAGE(PG8_SA(0, 1), cA + hstep, voffA);
        if (wr == 1) PG8_BAR;
        PG8_WAIT_V(2); PG8_BAR;
        PG8_STAGE(PG8_SB(1, 0), cB + kstep, voffB); PG8_STAGE(PG8_SA(1, 0), cA + kstep, voffA); PG8_STAGE(PG8_SB(1, 1), cB + hstep + kstep, voffB);
        PG8_WAIT_V(6); PG8_BAR;
    } else {
        PG8_STAGE(PG8_SB(0, 0), cB, voffB); PG8_STAGE(PG8_SA(0, 0), cA, voffA); PG8_STAGE(PG8_SB(0, 1), cB + hstep, voffB); PG8_STAGE(PG8_SA(0, 1), cA + hstep, voffA);
        if (wr == 1) PG8_BAR;
        PG8_WAIT_V(4); PG8_BAR;
        PG8_STAGE(PG8_SB(1, 0), cB + kstep, voffB); PG8_STAGE(PG8_SA(1, 0), cA + kstep, voffA); PG8_STAGE(PG8_SB(1, 1), cB + hstep + kstep, voffB);
        PG8_WAIT_V(6); PG8_BAR;
    }
    for (;;) {
        const bool has_next = S.next(ui + 1, nxt);
        const char* nA = has_next ? (const char*)g.A + (size_t)nxt.pm * tstep : cA; const char* nB = has_next ? (const char*)g.Bt + (size_t)nxt.pn * tstep : cB;
        for (int t = 0; t < nt; t += 2) {
            const bool last = (t == nt - 2);
            const char* a1 = cA + (size_t)(t + 1) * kstep;
            const char* a2 = last ? nA : cA + (size_t)(t + 2) * kstep; const char* b2 = last ? nB : cB + (size_t)(t + 2) * kstep;
            const char* a3 = a2 + kstep; const char* b3 = b2 + kstep;
            if (last && has_next) S.a_ready(nxt);
            if constexpr (SP2) {
            PG8_LDB(B0, 0, 0); PG8_LDB(B1, 0, 1); PG8_SCHED; PG8_LDA(At, 0, 0); PG8_STAGE(PG8_SA(1, 1), a1 + hstep, voffA);
            PG8_WAIT_V(8); PG8_WAIT_L(0); PG8_BAR; PG8_MMA(0, 0, At, B0); PG8_MMA(0, 1, At, B1); PG8_BAR; PG8_SCHED;
            PG8_LDA(At, 0, 1); PG8_STAGE(PG8_SB(0, 0), b2, voffB); PG8_STAGE(PG8_SB(0, 1), b2 + hstep, voffB); PG8_STAGE(PG8_SA(0, 0), a2, voffA);
            PG8_WAIT_V(8); PG8_WAIT_L(0); PG8_BAR; PG8_MMA(1, 0, At, B0); PG8_MMA(1, 1, At, B1); PG8_BAR; PG8_SCHED;
            PG8_LDB(B0, 1, 0); PG8_LDB(B1, 1, 1); PG8_SCHED; PG8_LDA(At, 1, 0); PG8_STAGE(PG8_SA(0, 1), a2 + hstep, voffA);
            PG8_WAIT_V(8); PG8_WAIT_L(0); PG8_BAR; PG8_MMA(0, 0, At, B0); PG8_MMA(0, 1, At, B1); PG8_BAR; PG8_SCHED;
            PG8_LDA(At, 1, 1); PG8_STAGE(PG8_SB(1, 0), b3, voffB); PG8_STAGE(PG8_SB(1, 1), b3 + hstep, voffB); PG8_STAGE(PG8_SA(1, 0), a3, voffA);
            PG8_WAIT_V(8); PG8_WAIT_L(0); PG8_BAR; PG8_MMA(1, 0, At, B0); PG8_MMA(1, 1, At, B1); PG8_BAR; PG8_SCHED;
            } else {
            PG8_LDB(B0, 0, 0); PG8_SCHED; PG8_LDA(At, 0, 0); PG8_STAGE(PG8_SA(1, 1), a1 + hstep, voffA);
            PG8_WAIT_L(8); PG8_BAR; PG8_WAIT_L(0); PG8_MMA(0, 0, At, B0); PG8_BAR; PG8_SCHED;
            PG8_LDB(B1, 0, 1); PG8_STAGE(PG8_SB(0, 0), b2, voffB);
            PG8_BAR; PG8_WAIT_L(0); PG8_MMA(0, 1, At, B1); PG8_BAR;
            PG8_LDA(At, 0, 1); PG8_STAGE(PG8_SA(0, 0), a2, voffA);
            PG8_BAR; PG8_WAIT_L(0); PG8_MMA(1, 0, At, B0); PG8_BAR; PG8_SCHED;
            PG8_STAGE(PG8_SB(0, 1), b2 + hstep, voffB);
            PG8_WAIT_V(6); PG8_BAR; PG8_MMA(1, 1, At, B1); PG8_BAR;
            PG8_LDB(B0, 1, 0); PG8_SCHED; PG8_LDA(At, 1, 0); PG8_STAGE(PG8_SA(0, 1), a2 + hstep, voffA);
            PG8_WAIT_L(8); PG8_BAR; PG8_WAIT_L(0); PG8_MMA(0, 0, At, B0); PG8_BAR; PG8_SCHED;
            PG8_LDB(B1, 1, 1); PG8_STAGE(PG8_SB(1, 0), b3, voffB);
            PG8_BAR; PG8_WAIT_L(0); PG8_MMA(0, 1, At, B1); PG8_BAR;
            PG8_LDA(At, 1, 1); PG8_STAGE(PG8_SA(1, 0), a3, voffA);
            PG8_BAR; PG8_WAIT_L(0); PG8_MMA(1, 0, At, B0); PG8_BAR; PG8_SCHED;
            PG8_STAGE(PG8_SB(1, 1), b3 + hstep, voffB);
            PG8_WAIT_V(6); PG8_BAR; PG8_MMA(1, 1, At, B1); PG8_BAR;
            }
        }
        if constexpr (ALIGN_EPI) { if (wr == 0) PG8_BAR; }
        if constexpr (!Epi::AFTER_DRAIN) { E(acc, cur, wr, wc, fr, fq); S.done(cur); }
        if (!has_next) break;
#pragma unroll
        for (int a = 0; a < 2; ++a)
#pragma unroll
            for (int b = 0; b < 2; ++b)
#pragma unroll
                for (int m = 0; m < 4; ++m)
#pragma unroll
                    for (int n = 0; n < 2; ++n) acc[a][b][m][n] = (f32x4){0.f, 0.f, 0.f, 0.f};
        cur = nxt; cA = nA; cB = nB; ++ui;
        if constexpr (ALIGN_EPI) { if (wr == 1) PG8_BAR; }
    }
    PG8_WAIT_V(0);
    if constexpr (!ALIGN_EPI) { if (wr == 0) PG8_BAR; }
    PG8_BAR;
    if constexpr (Epi::AFTER_DRAIN) { E.fused(acc, cur, wr, wc, fr, fq, lds, wid, lane); S.done(cur); }
#undef PG8_SA
#undef PG8_SB
#undef PG8_STAGE
#undef PG8_LDA
#undef PG8_LDB
#undef PG8_MMA
#undef PG8_WAIT_V
#undef PG8_WAIT_L
#undef PG8_BAR
#undef PG8_SCHED
}
}

#ifndef PG8_SP2
#define PG8_SP2 true
#endif
#ifndef PG8_ALIGN
#define PG8_ALIGN true
#endif
#include <hip/hip_bf16.h>
#include <cmath>
namespace attn_body {
using bf16=__hip_bfloat16;
using bf16x8=__attribute__((ext_vector_type(8)))short;
using s16x4=__attribute__((ext_vector_type(4)))short;
using f32x16=__attribute__((ext_vector_type(16)))float;
using u32x4=__attribute__((ext_vector_type(4)))unsigned;
using f32x4_t=__attribute__((ext_vector_type(4)))float;
typedef __attribute__((address_space(3))) const float* lds_fptr;
constexpr int BATCH=8,NHEAD=16,SEQ=4096,D=64,DM=NHEAD*D;
constexpr int NW=8,QBLK=32,QB=QBLK*NW,KVBLK=64,NQB=SEQ/QB;
constexpr int ATTN_PITCH=DM, ATTN_UNIT_ROWS=QB;
__device__ __forceinline__ int crow(int r,int hi){return (r&3)+8*(r>>2)+4*hi;}
#define SBAR() __builtin_amdgcn_sched_barrier(0)
__device__ __forceinline__ void cmask(f32x16&p0,f32x16&p1,int jb,int qrel,int hi){
  const float NEG=-INFINITY; int kb=64*jb+4*hi;
  #pragma unroll
  for(int r=0;r<16;++r){int kv=kb+(r&3)+8*(r>>2); if(kv>qrel)p0[r]=NEG; if(kv+32>qrel)p1[r]=NEG;}
}

constexpr int NSLOT=3, SLOTB=8192;
constexpr int LDS_K=0, LDS_V=NSLOT*SLOTB, LDS_WS=2*NSLOT*SLOTB, LDS_OST=LDS_WS+NW*64*4, LDS_BYTES=LDS_OST+NW*4096;
constexpr float C2=0.125f*1.4426950408889634f;
__device__ __forceinline__ void glds16(const void*gsrc,unsigned lds_dst){unsigned keep;
  asm volatile("s_mov_b32 %0, m0\n\ts_mov_b32 m0, %2\n\ts_nop 0\n\tglobal_load_lds_dwordx4 %1, off\n\ts_mov_b32 m0, %0":"=&s"(keep):"v"(gsrc),"s"(lds_dst):"memory");}
__device__ __forceinline__ float max3f(float a,float b,float c){float r;asm("v_max3_f32 %0, %1, %2, %3":"=v"(r):"v"(a),"v"(b),"v"(c));return r;}
__device__ __forceinline__ float max2f(float a,float b){float r;asm("v_max_f32_e32 %0, %1, %2":"=v"(r):"v"(a),"v"(b));return r;}
__device__ __forceinline__ float fadd_s(float a,float b){float r;asm("v_add_f32_e32 %0, %1, %2":"=v"(r):"v"(a),"v"(b));return r;}
__device__ __forceinline__ float fsub_s(float a,float b){float r;asm("v_sub_f32_e32 %0, %1, %2":"=v"(r):"v"(a),"v"(b));return r;}
typedef float f32x2_t __attribute__((ext_vector_type(2))); typedef __bf16 bf16x2_t __attribute__((ext_vector_type(2)));
__device__ __forceinline__ unsigned cvtpk_s(float lo,float hi){f32x2_t v={lo,hi};bf16x2_t b=__builtin_convertvector(v,bf16x2_t);return __builtin_bit_cast(unsigned,b);}
#define WAIT_BAR(N) asm volatile("s_waitcnt vmcnt(" #N ") lgkmcnt(0)\n\ts_barrier":::"memory")

__device__ __forceinline__ void qkt(f32x16&p0,f32x16&p1,const char*Kslot,const bf16x8*qr,int r32,int hi){
  const char*kb=Kslot+hi*1024+r32*16;
  #pragma unroll
  for(int d0=0;d0<4;++d0){
    const bf16x8 b0=*reinterpret_cast<const bf16x8*>(kb+d0*2048);
    const bf16x8 b1=*reinterpret_cast<const bf16x8*>(kb+d0*2048+512);
    p0=__builtin_amdgcn_mfma_f32_32x32x16_bf16(b0,qr[d0],p0,0,0,0);p1=__builtin_amdgcn_mfma_f32_32x32x16_bf16(b1,qr[d0],p1,0,0,0);}
}
typedef __attribute__((address_space(3))) const char* lds_cptr;
typedef short v4i16_t __attribute__((ext_vector_type(4)));
__device__ __forceinline__ void kload8(bf16x8*kf,lds_cptr kp){
  kf[0]=*(const __attribute__((address_space(3))) bf16x8*)(kp);      kf[1]=*(const __attribute__((address_space(3))) bf16x8*)(kp+512);
  kf[2]=*(const __attribute__((address_space(3))) bf16x8*)(kp+2048); kf[3]=*(const __attribute__((address_space(3))) bf16x8*)(kp+2560);
  kf[4]=*(const __attribute__((address_space(3))) bf16x8*)(kp+4096); kf[5]=*(const __attribute__((address_space(3))) bf16x8*)(kp+4608);
  kf[6]=*(const __attribute__((address_space(3))) bf16x8*)(kp+6144); kf[7]=*(const __attribute__((address_space(3))) bf16x8*)(kp+6656);
}
__device__ __forceinline__ void kload2(bf16x8*kf,lds_cptr kp,int j){ kf[2*j]=*(const __attribute__((address_space(3))) bf16x8*)(kp+j*2048); kf[2*j+1]=*(const __attribute__((address_space(3))) bf16x8*)(kp+j*2048+512); }
__device__ __forceinline__ s16x4 vtr(lds_cptr p){ return __builtin_bit_cast(s16x4,__builtin_amdgcn_ds_read_tr16_b64_v4i16((__attribute__((address_space(3))) v4i16_t*)p)); }
__device__ __forceinline__ float rowmax(const f32x16&p0,const f32x16&p1){
  float a=max3f(p0[0],p0[1],p1[0]),b=max3f(p0[2],p0[3],p1[1]);a=max3f(a,p1[2],p1[3]);
  #pragma unroll
  for(int r=4;r<16;r+=4){a=max3f(a,p0[r],p0[r+1]);b=max3f(b,p0[r+2],p0[r+3]);a=max3f(a,p1[r],p1[r+1]);b=max3f(b,p1[r+2],p1[r+3]);}
  const float m=max2f(a,b);
  auto rr=__builtin_amdgcn_permlane32_swap(__float_as_uint(m),__float_as_uint(m),false,false);
  return max2f(__uint_as_float(rr[0]),__uint_as_float(rr[1]));
}
__device__ __forceinline__ void pv(f32x16*o,int vb,bf16x8 pa0,bf16x8 pa1,bf16x8 pa2,bf16x8 pa3){
  #pragma unroll
  for(int d0=0;d0<2;++d0){s16x4 lo[4],hi[4];
    #pragma unroll
    for(int ks=0;ks<4;++ks){
      asm volatile("ds_read_b64_tr_b16 %0,%1 offset:%c2":"=&v"(lo[ks]):"v"(vb),"i"(d0*4096+ks*1024):"memory");
      asm volatile("ds_read_b64_tr_b16 %0,%1 offset:%c2":"=&v"(hi[ks]):"v"(vb),"i"(d0*4096+ks*1024+512):"memory");}
    asm volatile("s_waitcnt lgkmcnt(0)":::"memory");SBAR();
    #define PK(k) (bf16x8){lo[k][0],lo[k][1],lo[k][2],lo[k][3],hi[k][0],hi[k][1],hi[k][2],hi[k][3]}
    o[d0]=__builtin_amdgcn_mfma_f32_32x32x16_bf16(pa0,PK(0),o[d0],0,0,0);
    o[d0]=__builtin_amdgcn_mfma_f32_32x32x16_bf16(pa1,PK(1),o[d0],0,0,0);
    o[d0]=__builtin_amdgcn_mfma_f32_32x32x16_bf16(pa2,PK(2),o[d0],0,0,0);
    o[d0]=__builtin_amdgcn_mfma_f32_32x32x16_bf16(pa3,PK(3),o[d0],0,0,0);
    #undef PK
  }
}

#ifndef ATTN_STORE16
#define ATTN_STORE16(p,v) (*(u32x4*)(p)=(v))
#endif
template<int THRL> __device__ __forceinline__ void attn_unit(int b,int h,int qb,const bf16*Q,const bf16*__restrict__ K,const bf16*__restrict__ V,bf16*O,char*shm,lds_fptr kbl){
  int tid=threadIdx.x; asm volatile("":"+v"(tid)); const int lane=tid&63,r32=lane&31,hi=lane>>5; const int wid=__builtin_amdgcn_readfirstlane(tid>>6);
  const long rowbase=(long)b*SEQ; const int q0=qb*QB;
  const bf16*Qw=Q+(rowbase+q0+wid*QBLK)*DM+h*D;
  const bf16*Kh=K+rowbase*DM+h*D,*Vh=V+rowbase*DM+h*D;
  const unsigned lds0=(unsigned)(uintptr_t)shm;
  float*wsf=(float*)(shm+LDS_WS)+wid*64;
  const bf16*ksrc=Kh+(long)lane*DM+wid*8;
  const bf16*vsrc=Vh+(long)(16*(wid&3)+(lane>>2))*DM+(wid>>2)*32+(lane&3)*8;
  const unsigned kdst=lds0+LDS_K+wid*1024, vdst=lds0+LDS_V+wid*1024;
  #define DMA_K(t,slot) glds16(ksrc+(long)(t)*KVBLK*DM,(unsigned)__builtin_amdgcn_readfirstlane(kdst+(slot)))
  #define DMA_V(t,slot) glds16(vsrc+(long)(t)*KVBLK*DM,(unsigned)__builtin_amdgcn_readfirstlane(vdst+(slot)))
  const int vb0=(int)(lds0+LDS_V)+((lane>>4)&1)*32+(lane&3)*8+(4*hi+((lane&15)>>2))*64;
  const char*Kbase=shm+LDS_K; bf16x8 kf[8];
  const lds_cptr shm3=(lds_cptr)shm; const lds_cptr kp0=shm3+LDS_K+hi*1024+r32*16; const lds_cptr vp0=shm3+LDS_V+((lane>>4)&1)*32+(lane&3)*8+(4*hi+((lane&15)>>2))*64;
  const int NT=(q0+QB)/KVBLK;
  DMA_K(0,0);DMA_V(0,0);DMA_K(1,SLOTB);
  bf16x8 qr[4];
  #pragma unroll
  for(int d0=0;d0<4;++d0)qr[d0]=*reinterpret_cast<const bf16x8*>(&Qw[(long)r32*DM+d0*16+hi*8]);
  float mhat=0.f,l_reg=0.f;f32x16 o[2];o[0]=f32x16{};o[1]=f32x16{};
  const lds_fptr kbh=kbl+4*hi;
  #define KBLOAD(X0,X1,t) do{ const lds_fptr kb_=kbh+(t)*64; _Pragma("unroll") for(int g_=0;g_<4;++g_){ const f32x4_t a_=*(const __attribute__((address_space(3))) f32x4_t*)(kb_+8*g_), b_=*(const __attribute__((address_space(3))) f32x4_t*)(kb_+32+8*g_); _Pragma("unroll") for(int i_=0;i_<4;++i_){X0[4*g_+i_]=a_[i_];X1[4*g_+i_]=b_[i_];} } }while(0)
  #define KBSUB(C0,C1) do{ _Pragma("unroll") for(int r_=0;r_<16;++r_){C0[r_]-=mhat;C1[r_]-=mhat;} }while(0)
  #define KBINIT(C0,C1,t) do{ KBLOAD(C0,C1,t); KBSUB(C0,C1); }while(0)
  const int qrel=wid*QBLK+r32;
  #define CMASK(P0,P1,t) do{int jb_=(t)-(NT-4); if(jb_>=0)cmask(P0,P1,jb_,qrel,hi);}while(0)
  bool resc=false;
  #define START(P0,P1) do{ const float rm=rowmax(P0,P1); resc=false; \
    { const float dl=rm; mhat=fadd_s(mhat,dl); \
      _Pragma("unroll") for(int r=0;r<16;++r){P0[r]=fsub_s(P0[r],dl);P1[r]=fsub_s(P1[r],dl);} } \
    _Pragma("unroll") for(int r=0;r<16;++r)P0[r]=__builtin_amdgcn_exp2f(P0[r]); }while(0)
  #define RESC() do{ if(resc){ asm volatile("s_waitcnt lgkmcnt(0)":::"memory"); \
      _Pragma("unroll") for(int d_=0;d_<2;++d_) _Pragma("unroll") for(int r=0;r<16;++r)o[d_][r]*=wsf[crow(r,hi)]; } }while(0)
  f32x16 pA0,pA1,pB0,pB1;
  int sl_prev=0,sl_cur=0,sl_next=SLOTB;
  #define ROT() do{sl_prev=sl_cur;sl_cur=sl_next;sl_next=(sl_next==(NSLOT-1)*SLOTB)?0:sl_next+SLOTB;}while(0)
  DMA_K(2,2*SLOTB);
  WAIT_BAR(3);
  KBINIT(pA0,pA1,0); qkt(pA0,pA1,Kbase,qr,r32,hi);asm volatile("s_nop 15\n\ts_nop 7":"+v"(pA0),"+v"(pA1));CMASK(pA0,pA1,0);
  START(pA0,pA1);
  _Pragma("unroll") for(int r=0;r<16;++r)pA1[r]=__builtin_amdgcn_exp2f(pA1[r]);
  WAIT_BAR(0);
  DMA_K(3,0);DMA_V(1,SLOTB);
  ROT();
  kload8(kf,kp0+sl_cur);
  WAIT_BAR(2);
  s16x4 vlo[8],vhi[8]; u32x4 pw0,pw1,pw2,pw3;
  #define PKW(P,B) cvtpk_s(P[B],P[B+1])
  #define PAF(k) __builtin_bit_cast(bf16x8,pw##k)
  #define VFR(i) (bf16x8){vlo[i][0],vlo[i][1],vlo[i][2],vlo[i][3],vhi[i][0],vhi[i][1],vhi[i][2],vhi[i][3]}
  #define PIN(x) asm volatile("":"+v"(x))
  #define MX3(a,b,c) __builtin_fmaxf(__builtin_fmaxf((a),(b)),(c))
  #define GAPA(MF,A0,A1,A2,A3,W0,W1,PW) do{ MF; sacc+=A0; sacc+=A1; sacc+=A2; sacc+=A3; PIN(sacc); W0; W1; PIN(PW); SBAR(); }while(0)
  #define EX(v) __builtin_amdgcn_exp2f(v)
  #define GAPB(MF,X,B) do{ MF; X[B]=EX(X[B]); X[B+1]=EX(X[B+1]); X[B+2]=EX(X[B+2]); X[B+3]=EX(X[B+3]); PIN(X); SBAR(); }while(0)
  #define VRD(i) do{ vlo[i]=vtr(vp_+(((i)>>2)*4096+((i)&3)*1024)); vhi[i]=vtr(vp_+(((i)>>2)*4096+((i)&3)*1024+512)); }while(0)
  #define KRD(G,j) do{ if(G){ kload2(kf,kp0+sl_next,j); SBAR(); } }while(0)
  #define STEP(C0,C1,P0,P1,t,GK,GV,GL) do{ KBSUB(C0,C1); SBAR(); \
    const lds_cptr vp_=vp0+sl_prev; \
    VRD(0); SBAR(); float sacc=(P0[0]+P0[1]); \
    GAPA(C0=__builtin_amdgcn_mfma_f32_32x32x16_bf16(kf[0],qr[0],C0,0,0,0), P0[2],P0[3],P0[4],P0[5],     pw0[0]=PKW(P0,0), pw0[1]=PKW(P0,2), pw0); \
    VRD(4); SBAR(); GAPA(C1=__builtin_amdgcn_mfma_f32_32x32x16_bf16(kf[1],qr[0],C1,0,0,0), P0[6],P0[7],P0[8],P0[9],     pw0[2]=PKW(P0,4), pw0[3]=PKW(P0,6), pw0); \
    VRD(1); SBAR(); GAPA(C0=__builtin_amdgcn_mfma_f32_32x32x16_bf16(kf[2],qr[1],C0,0,0,0),   P0[10],P0[11],P0[12],P0[13], pw1[0]=PKW(P0,8), pw1[1]=PKW(P0,10), pw1); \
    VRD(5); SBAR(); GAPA(C1=__builtin_amdgcn_mfma_f32_32x32x16_bf16(kf[3],qr[1],C1,0,0,0),   P0[14],P0[15],P1[0],P1[1],   pw1[2]=PKW(P0,12),pw1[3]=PKW(P0,14), pw1); \
    VRD(2); SBAR(); GAPA(C0=__builtin_amdgcn_mfma_f32_32x32x16_bf16(kf[4],qr[2],C0,0,0,0),   P1[2],P1[3],P1[4],P1[5],     pw2[0]=PKW(P1,0), pw2[1]=PKW(P1,2), pw2); \
    VRD(6); SBAR(); GAPA(C1=__builtin_amdgcn_mfma_f32_32x32x16_bf16(kf[5],qr[2],C1,0,0,0),   P1[6],P1[7],P1[8],P1[9],     pw2[2]=PKW(P1,4), pw2[3]=PKW(P1,6), pw2); \
    VRD(3); SBAR(); GAPA(C0=__builtin_amdgcn_mfma_f32_32x32x16_bf16(kf[6],qr[3],C0,0,0,0),   P1[10],P1[11],P1[12],P1[13], pw3[0]=PKW(P1,8), pw3[1]=PKW(P1,10), pw3); \
    VRD(7); SBAR(); GAPA(C1=__builtin_amdgcn_mfma_f32_32x32x16_bf16(kf[7],qr[3],C1,0,0,0),   P1[14],P1[15],0.f,0.f,       pw3[2]=PKW(P1,12),pw3[3]=PKW(P1,14), pw3); \
    l_reg+=sacc; if((t)+1<NT){ KBLOAD(P0,P1,(t)+1); } \
    if(GK){DMA_K((t)+3,sl_cur);} if(GV){DMA_V((t)+1,sl_next);} \
    CMASK(C0,C1,t); \
    { float a=MX3(C0[0],C0[1],C1[0]),b=MX3(C0[2],C0[3],C1[1]); a=MX3(a,C1[2],C1[3]); \
      _Pragma("unroll") for(int r=4;r<16;r+=4){a=MX3(a,C0[r],C0[r+1]);b=MX3(b,C0[r+2],C0[r+3]);a=MX3(a,C1[r],C1[r+1]);b=MX3(b,C1[r+2],C1[r+3]);} \
      float rm=__builtin_fmaxf(a,b); { auto rr=__builtin_amdgcn_permlane32_swap(__float_as_uint(rm),__float_as_uint(rm),false,false); rm=__builtin_fmaxf(__uint_as_float(rr[0]),__uint_as_float(rr[1])); } \
      resc=false; \
      if(__builtin_expect(__any(rm>(float)THRL),0)){ const float dl=__builtin_fmaxf(rm,0.f); mhat+=dl; \
        _Pragma("unroll") for(int r=0;r<16;++r){C0[r]-=dl;C1[r]-=dl;} \
        const float f=__builtin_amdgcn_exp2f(-dl); l_reg*=f; if(hi==0)wsf[r32]=f; resc=true; } } \
    SBAR(); \
    GAPB(o[0]=__builtin_amdgcn_mfma_f32_32x32x16_bf16(PAF(0),VFR(0),o[0],0,0,0), C0,0); \
    GAPB(o[1]=__builtin_amdgcn_mfma_f32_32x32x16_bf16(PAF(0),VFR(4),o[1],0,0,0), C0,4); \
    KRD(GL,0); GAPB(o[0]=__builtin_amdgcn_mfma_f32_32x32x16_bf16(PAF(1),VFR(1),o[0],0,0,0), C0,8); \
    KRD(GL,1); GAPB(o[1]=__builtin_amdgcn_mfma_f32_32x32x16_bf16(PAF(1),VFR(5),o[1],0,0,0), C0,12); \
    KRD(GL,2); GAPB(o[0]=__builtin_amdgcn_mfma_f32_32x32x16_bf16(PAF(2),VFR(2),o[0],0,0,0), C1,0); \
    KRD(GL,3); GAPB(o[1]=__builtin_amdgcn_mfma_f32_32x32x16_bf16(PAF(2),VFR(6),o[1],0,0,0), C1,4); \
    GAPB(o[0]=__builtin_amdgcn_mfma_f32_32x32x16_bf16(PAF(3),VFR(3),o[0],0,0,0), C1,8); \
    GAPB(o[1]=__builtin_amdgcn_mfma_f32_32x32x16_bf16(PAF(3),VFR(7),o[1],0,0,0), C1,12); \
    }while(0)
  int t=1; KBLOAD(pB0,pB1,1);
  #undef CMASK
  #define CMASK(P0,P1,t) do{}while(0)
  for(;t+5<NT;t+=2){
    STEP(pB0,pB1,pA0,pA1,t,true,true,true);     WAIT_BAR(2); RESC(); ROT();
    STEP(pA0,pA1,pB0,pB1,t+1,true,true,true);   WAIT_BAR(2); RESC(); ROT();
  }
  #undef CMASK
  #define CMASK(P0,P1,t) do{int jb_=(t)-(NT-4); if(jb_>=0)cmask(P0,P1,jb_,qrel,hi);}while(0)
  #define ENDW(tt) do{ if((tt)+3<NT){WAIT_BAR(2);} else if((tt)+2<NT){WAIT_BAR(1);} else {WAIT_BAR(0);} }while(0)
  for(;t+1<NT;t+=2){
    STEP(pB0,pB1,pA0,pA1,t,(t+3<NT),(t+1<NT),(t+1<NT));       ENDW(t);   RESC(); ROT();
    STEP(pA0,pA1,pB0,pB1,t+1,(t+4<NT),(t+2<NT),(t+2<NT));     ENDW(t+1); RESC(); ROT();
  }
  STEP(pB0,pB1,pA0,pA1,NT-1,false,false,false); RESC();
  { float sacc=pB0[0]+pB0[1]; _Pragma("unroll") for(int r=2;r<16;++r)sacc+=pB0[r]; _Pragma("unroll") for(int r=0;r<16;++r)sacc+=pB1[r]; l_reg+=sacc;
    pw0=(u32x4){PKW(pB0,0),PKW(pB0,2),PKW(pB0,4),PKW(pB0,6)};pw1=(u32x4){PKW(pB0,8),PKW(pB0,10),PKW(pB0,12),PKW(pB0,14)};pw2=(u32x4){PKW(pB1,0),PKW(pB1,2),PKW(pB1,4),PKW(pB1,6)};pw3=(u32x4){PKW(pB1,8),PKW(pB1,10),PKW(pB1,12),PKW(pB1,14)};
    SBAR(); pv(o,vb0+sl_cur,PAF(0),PAF(1),PAF(2),PAF(3)); }
  #undef PKW
  #undef PAF
  #undef VFR
  #undef PIN
  #undef MX3
  #undef GAPA
  #undef GAPB
  #undef EX
  #undef VRD
  #undef KRD
  #undef STEP
  #undef ENDW
  {auto rr=__builtin_amdgcn_permlane32_swap(__float_as_uint(l_reg),__float_as_uint(l_reg),false,false);l_reg=__uint_as_float(rr[0])+__uint_as_float(rr[1]);}
  if(hi==0)wsf[32+r32]=l_reg;asm volatile("s_waitcnt lgkmcnt(0)":::"memory");
  float rli[16];
  #pragma unroll
  for(int r=0;r<16;++r)rli[r]=__builtin_amdgcn_rcpf(wsf[32+crow(r,hi)]);
  bf16*Ow=O+(rowbase+q0+wid*QBLK)*DM+h*D;
  { bf16*stg=(bf16*)(shm+LDS_OST)+wid*2048;
    #pragma unroll
    for(int r=0;r<16;++r){const int orow=crow(r,hi);
      #pragma unroll
      for(int d0=0;d0<2;++d0)stg[orow*64+d0*32+r32]=__float2bfloat16(o[d0][r]*rli[r]);}
    asm volatile("s_waitcnt lgkmcnt(0)":::"memory");
    #pragma unroll
    for(int i=0;i<4;++i){const int row=i*8+(lane>>3),ch=lane&7; const u32x4 v=*(const u32x4*)(stg+row*64+ch*8); ATTN_STORE16(Ow+(long)row*DM+ch*8,v);} }
  asm volatile("s_waitcnt lgkmcnt(0)\n\ts_barrier":::"memory");
  #undef DMA_K
  #undef DMA_V
  #undef CMASK
  #undef START
  #undef RESC
  #undef ROT
  #undef KBINIT
  #undef KBLOAD
  #undef KBSUB
}
constexpr int ATTN_LDS_BYTES=LDS_BYTES;
struct AttnTensors { const bf16* Q; const bf16* K; const bf16* V; bf16* O; };
struct AttnUnit { int bh; int qb; };
struct StaticOrder {
  int vcu;
  __device__ __forceinline__ explicit StaticOrder(int grid,int block):vcu((block%8)*(grid/8)+block/8){}
  __device__ __forceinline__ bool next(int i,AttnUnit&u)const{ if(i>=8)return false; const int s=4*(vcu&1)+(i>>1); u.bh=vcu>>1; u.qb=(i&1)?15-s:s; return true; }
  __device__ __forceinline__ void a_ready(const AttnUnit&)const{}
  __device__ __forceinline__ void done(const AttnUnit&)const{}
};
template<class Sched,int THRL=8> __device__ __forceinline__ void attn_phase(char*lds,const AttnTensors&T,const Sched&S,lds_fptr kbl){
  AttnUnit u;
  for(int i=0;S.next(i,u);++i){ S.a_ready(u); attn_unit<THRL>(u.bh/NHEAD,u.bh%NHEAD,u.qb,T.Q,T.K,T.V,T.O,lds,kbl); S.done(u); }
}
#undef SBAR
#undef WAIT_BAR
}
#define GAS __attribute__((address_space(1)))
#define LAS __attribute__((address_space(3)))
typedef unsigned short bf16;
typedef unsigned v4u __attribute__((ext_vector_type(4)));
typedef float f32x4 __attribute__((ext_vector_type(4)));
typedef short bf16x8 __attribute__((ext_vector_type(8)));
typedef GAS unsigned gu32;
typedef GAS unsigned long long gu64;
#define RLX_AGENT __ATOMIC_RELAXED, __HIP_MEMORY_SCOPE_AGENT
#define LDS_WAIT() asm volatile("s_waitcnt lgkmcnt(0)" ::: "memory")
#define VM_WAIT() asm volatile("s_waitcnt vmcnt(0)" ::: "memory")
__device__ __forceinline__ unsigned long long rt() { return __builtin_amdgcn_s_memrealtime(); }
__device__ __forceinline__ unsigned f2bf(float f) { unsigned u = __builtin_bit_cast(unsigned, f); return (u + 0x7fffu + ((u >> 16) & 1u)) >> 16; }
__device__ __forceinline__ unsigned pk2(float lo, float hi) { return f2bf(lo) | (f2bf(hi) << 16); }

#define XB_TMO      128
#define XB_XCNT(j)  (256  + 64 * (j))
#define XB_XSUB(j)  (1280 + 64 * (j))
#define XB_XGEN(j)  (2304 + 64 * (j))
#define XB_TOP      3328
#define XB_TOPGEN   3392
#define XCD_BAR_WORDS 3456
#define XB_SPIN_CAP (1u << 18)

__device__ __forceinline__ unsigned xb_ld(unsigned* p)              { return __hip_atomic_load(p, __ATOMIC_RELAXED, __HIP_MEMORY_SCOPE_AGENT); }
__device__ __forceinline__ unsigned xb_add(unsigned* p, unsigned v) { return __hip_atomic_fetch_add(p, v, __ATOMIC_RELAXED, __HIP_MEMORY_SCOPE_AGENT); }
__device__ __forceinline__ unsigned xb_xcc_id() { return (unsigned)__builtin_amdgcn_s_getreg((3 << 11) | 20) & 0xFu; }
#define XB_SPIN(cond, bar) do { unsigned _sp = 0; while (cond) { __builtin_amdgcn_s_sleep(1); \
    if ((++_sp & 255u) == 0u) { if (xb_ld(&(bar)[XB_TMO])) break; if (_sp > XB_SPIN_CAP) { atomicAdd(&(bar)[XB_TMO], 1u); break; } } } } while (0)

struct XcdBarrier {
    unsigned* bar; unsigned x;
    volatile LAS unsigned* st;
};

__device__ __forceinline__ XcdBarrier xcd_barrier_post(unsigned* bar, volatile LAS unsigned* st) {
    XcdBarrier b; b.bar = bar; b.x = xb_xcc_id(); b.st = st;
    if (threadIdx.x == 0) (void)xb_add(&bar[XB_XCNT(b.x)], 1u);
    return b;
}
__device__ __forceinline__ void xcd_barrier_complete(unsigned* bar, unsigned x, unsigned& nloc, unsigned& nx) {
    const unsigned G = gridDim.x * gridDim.y * gridDim.z;
    unsigned sum, cnt, mine, sp = 0u;
    for (;;) {
        sum = 0u; cnt = 0u; mine = 0u;
#pragma unroll
        for (unsigned j = 0; j < 16; ++j) { const unsigned c = xb_ld(&bar[XB_XCNT(j)]); sum += c; cnt += (c > 0u) ? 1u : 0u; mine = (j == x) ? c : mine; }
        if (sum == G) break;
        __builtin_amdgcn_s_sleep(1);
        if ((++sp & 255u) == 0u) { if (xb_ld(&bar[XB_TMO])) break; if (sp > XB_SPIN_CAP) { atomicAdd(&bar[XB_TMO], 1u); break; } }
    }
    nloc = mine > 0u ? mine : 1u; nx = cnt > 0u ? cnt : 1u;
}

__device__ __forceinline__ void xcd_barrier(const XcdBarrier& b) {
    asm volatile("s_waitcnt vmcnt(0)" ::: "memory");
    __syncthreads();
    if (threadIdx.x == 0) {
        unsigned* bar = b.bar; const unsigned myx = xb_xcc_id();
        __builtin_amdgcn_s_waitcnt(0);
        unsigned nloc = b.st[0], nx = b.st[1];
        if (nloc == 0u) { xcd_barrier_complete(bar, myx, nloc, nx); b.st[0] = nloc; b.st[1] = nx; }
        const unsigned old = xb_add(&bar[XB_XSUB(myx)], 1u);
        const unsigned gen = old / nloc;
        if (old + 1u == (gen + 1u) * nloc) {
            __builtin_amdgcn_fence(__ATOMIC_RELEASE, "agent");
            asm volatile("s_waitcnt vmcnt(0)" ::: "memory");
            const unsigned og = xb_add(&bar[XB_TOP], 1u);
            const unsigned tg = og / nx;
            if (og + 1u == (tg + 1u) * nx) xb_add(&bar[XB_TOPGEN], 1u);
            else XB_SPIN(xb_ld(&bar[XB_TOPGEN]) == tg, bar);
            __builtin_amdgcn_fence(__ATOMIC_ACQUIRE, "agent");
            xb_add(&bar[XB_XGEN(myx)], 1u);
            asm volatile("s_waitcnt vmcnt(0)" ::: "memory");
        } else {
            XB_SPIN(xb_ld(&bar[XB_XGEN(myx)]) == gen, bar);
            __builtin_amdgcn_fence(__ATOMIC_ACQUIRE, "agent");
            asm volatile("s_waitcnt vmcnt(0)" ::: "memory");
        }
    }
    __syncthreads();
}

constexpr int NWAVES = 8, NTHR = 512;
constexpr int NB = 8, SEQ = 4096, D = 1024, M = NB * SEQ, NH = 16;
constexpr int NEXP = 16384, NSEL = 128;
constexpr float LN_EPS = 1e-5f;
constexpr float DN_ALPHA = 1.41421356237309515f;
constexpr int NAI = 3088, NAI_PAD = 3328;

constexpr size_t MiB = 1u << 20;
constexpr size_t WS_CTL = 0, CTL_ZERO_BYTES = 1 * MiB;
constexpr size_t WS_MOD = 512 * 1024;
constexpr size_t WS_SKB = 1 * MiB;
constexpr size_t WS_LOGF = 2 * MiB;
constexpr size_t WS_WCI = 8 * MiB, WS_WCO = 12 * MiB, WS_WAI = 14 * MiB, WS_WAO = 21 * MiB, WS_WPQ = 23 * MiB;
constexpr size_t WS_SC = 4 * MiB;
constexpr size_t WS_EXP = 32 * MiB;
constexpr size_t WS_HB = 160 * MiB;
constexpr size_t WS_BIG = 224 * MiB;
constexpr size_t WS_IDX = 416 * MiB, WS_GATE = 432 * MiB, WS_HB8 = 448 * MiB, WS_HS = 480 * MiB, WS_WCI8 = 481 * MiB, WS_WAI8 = 483 * MiB, WS_WPQ8 = 487 * MiB, WS_WSC = 491 * MiB, WS_WCO8 = 491 * MiB + 512 * 1024, WS_END = 493 * MiB;
constexpr int CW_BAR = 4096;

constexpr int RING_OFF = 0, RING_BYTES = 131072;
constexpr int LDSCTL_OFF = RING_BYTES, MISC_OFF = LDSCTL_OFF + 320;
constexpr int LDS_BYTES = 147456;
constexpr int KB_OFF = 98304;

#ifndef NREP_GEMM
#define NREP_GEMM 1
#endif
#ifndef NREP_TOPK
#define NREP_TOPK 1
#endif
#ifndef NREP_ATTN
#define NREP_ATTN 1
#endif
#ifndef NREP_GATHER
#define NREP_GATHER 1
#endif
#ifndef NREP_CONV
#define NREP_CONV 1
#endif
#ifndef NREP_PU
#define NREP_PU 1
#endif
#ifndef NREP_PV
#define NREP_PV 1
#endif
#ifndef PHM
#define PHM 0xFFFF
#endif
struct Args { const float* in[27]; float* out; unsigned char* ws; };

__device__ __forceinline__ float wave_sum(float v) {
#pragma unroll
    for (int o = 1; o < 64; o <<= 1) v += __shfl_xor(v, o);
    return v;
}
template <int CTRL> __device__ __forceinline__ float dpp_f(float v) { return __uint_as_float((unsigned)__builtin_amdgcn_update_dpp(0, (int)__float_as_uint(v), CTRL, 0xF, 0xF, true)); }
__device__ __forceinline__ float wave_max_nl(float v) {
    v = fmaxf(v, dpp_f<0x128>(v)); v = fmaxf(v, dpp_f<0x124>(v)); v = fmaxf(v, dpp_f<0x122>(v)); v = fmaxf(v, dpp_f<0x121>(v));
    v = fmaxf(v, __uint_as_float((unsigned)__builtin_amdgcn_ds_swizzle((int)__float_as_uint(v), 0x401F)));
    auto rr = __builtin_amdgcn_permlane32_swap(__float_as_uint(v), __float_as_uint(v), false, false);
    return fmaxf(__uint_as_float(rr[0]), __uint_as_float(rr[1]));
}
__device__ __forceinline__ float bf_lo(unsigned w) { return __uint_as_float(w << 16); }
__device__ __forceinline__ float bf_hi(unsigned w) { return __uint_as_float(w & 0xffff0000u); }
__device__ __forceinline__ float sigmoidf_(float x) { return 1.f / (1.f + __expf(-x)); }

namespace pg8 {
struct EpiGlu {
    static constexpr bool PERM = true, AFTER_DRAIN = false;
    bf16_t* O; const float* bias;
    __device__ __forceinline__ void operator()(const f32x4 (&acc)[2][2][4][2], const Unit& u, int wr, int wc, int fr, int fq) const {
        const int row0 = u.pm * BM + wr * 64 + fr; const int ocol = u.pn * 128 + wc * 32 + 8 * fq;
        f32x4 bl[2], bg[2];
#pragma unroll
        for (int n = 0; n < 2; ++n) { bl[n] = *(const f32x4*)(bias + ocol + 4 * n); bg[n] = *(const f32x4*)(bias + 1024 + ocol + 4 * n); }
#pragma unroll
        for (int ai = 0; ai < 2; ++ai)
#pragma unroll
            for (int m = 0; m < 4; ++m) {
                float v[8];
#pragma unroll
                for (int n = 0; n < 2; ++n)
#pragma unroll
                    for (int i = 0; i < 4; ++i) { const float l = acc[ai][0][m][n][i] + bl[n][i], g = acc[ai][1][m][n][i] + bg[n][i]; v[4 * n + i] = l / (1.f + __expf(-g)); }
                u32x4 w; w.x = cvt_pk_bf16(v[0], v[1]); w.y = cvt_pk_bf16(v[2], v[3]); w.z = cvt_pk_bf16(v[4], v[5]); w.w = cvt_pk_bf16(v[6], v[7]);
                *(u32x4*)(O + (size_t)(row0 + ai * HALF + m * 16) * 1024 + ocol) = w;
            }
    }
};
struct EpiQkvf {
    static constexpr bool PERM = true, AFTER_DRAIN = false;
    EpiBf16<0> inner; float* logf_t; const float* bias;
    __device__ __forceinline__ void operator()(const f32x4 (&acc)[2][2][4][2], const Unit& u, int wr, int wc, int fr, int fq) const {
        if (u.pn < 12) { inner(acc, u, wr, wc, fr, fq); return; }
        if (wc == 0 && fq < 2) {
            const int row0 = u.pm * BM + wr * 64 + fr;
#pragma unroll
            for (int ai = 0; ai < 2; ++ai)
#pragma unroll
                for (int m = 0; m < 4; ++m) { const int row = row0 + ai * HALF + m * 16; const int b = row >> 12, s = row & 4095;
#pragma unroll
                    for (int n = 0; n < 2; ++n)
#pragma unroll
                        for (int i = 0; i < 4; ++i) { const int col = 8 * fq + 4 * n + i; const float v = acc[ai][0][m][n][i] + bias[3072 + col];
                            const float lf = fminf(v, 0.f) - log1pf(__expf(-fabsf(v)));
                            logf_t[((size_t)(b * 16 + col) << 12) + s] = lf; } }
        }
    }
};
__device__ __forceinline__ f32x4 cvt_i8acc(const f32x4 a, float rsv, const f32x4 csv) { typedef int v4i_t __attribute__((ext_vector_type(4))); const v4i_t t = __builtin_bit_cast(v4i_t, a);
    return (f32x4){(float)t[0], (float)t[1], (float)t[2], (float)t[3]} * rsv * csv; }
struct EpiBf16I8 {
    static constexpr bool PERM = true, AFTER_DRAIN = false;
    bf16_t* O; int ldc; const float* bias; int split_cols; size_t split_stride; float scale0; const float* rs; const float* cs;
    __device__ __forceinline__ void operator()(const f32x4 (&acc)[2][2][4][2], const Unit& u, int wr, int wc, int fr, int fq) const {
        const int row0 = u.pm * BM + wr * 64 + fr; int colt = u.pn * BM; bf16_t* base = O;
        float sc = 1.f; if (split_cols) { const int t = colt / split_cols; base += (size_t)t * split_stride; colt -= t * split_cols; if (t == 0) sc = scale0; }
        const int col0 = colt + wc * 32 + 8 * fq, bcol0 = u.pn * BM + wc * 32 + 8 * fq;
#pragma unroll
        for (int bj = 0; bj < 2; ++bj) {
            f32x4 bv[2], cv[2];
#pragma unroll
            for (int n = 0; n < 2; ++n) { bv[n] = bias ? *(const f32x4*)(bias + bcol0 + bj * HALF + 4 * n) : (f32x4){0.f, 0.f, 0.f, 0.f}; cv[n] = *(const f32x4*)(cs + bcol0 + bj * HALF + 4 * n); }
#pragma unroll
            for (int ai = 0; ai < 2; ++ai)
#pragma unroll
                for (int m = 0; m < 4; ++m) { const int row = row0 + ai * HALF + m * 16; const float rsv = rs[row]; bf16_t* rowp = base + (size_t)row * ldc + col0;
                    const f32x4 v0 = (cvt_i8acc(acc[ai][bj][m][0], rsv, cv[0]) + bv[0]) * sc, v1 = (cvt_i8acc(acc[ai][bj][m][1], rsv, cv[1]) + bv[1]) * sc;
                    u32x4 w; w.x = cvt_pk_bf16(v0[0], v0[1]); w.y = cvt_pk_bf16(v0[2], v0[3]); w.z = cvt_pk_bf16(v1[0], v1[1]); w.w = cvt_pk_bf16(v1[2], v1[3]);
                    *(u32x4*)(rowp + bj * HALF) = w; }
        }
    }
};
struct EpiPqI8 {
    static constexpr bool PERM = true, AFTER_DRAIN = false;
    bf16_t* O; const float* rs; const float* cs;
    __device__ __forceinline__ void operator()(const f32x4 (&acc)[2][2][4][2], const Unit& u, int wr, int wc, int fr, int fq) const {
        const int row0 = u.pm * BM + wr * 64 + fr; const int bcol0 = u.pn * BM + wc * 32 + 8 * fq; const int ks = 2 * wc + (fq >> 1), hi = fq & 1;
#pragma unroll
        for (int bj = 0; bj < 2; ++bj) {
            f32x4 cv[2];
#pragma unroll
            for (int n = 0; n < 2; ++n) cv[n] = *(const f32x4*)(cs + bcol0 + bj * HALF + 4 * n);
#pragma unroll
            for (int ai = 0; ai < 2; ++ai)
#pragma unroll
                for (int m = 0; m < 4; ++m) { const int row = row0 + ai * HALF + m * 16; const float rsv = rs[row];
                    const f32x4 v0 = cvt_i8acc(acc[ai][bj][m][0], rsv, cv[0]), v1 = cvt_i8acc(acc[ai][bj][m][1], rsv, cv[1]);
                    u32x4 w; w.x = cvt_pk_bf16(v0[0], v0[1]); w.y = cvt_pk_bf16(v0[2], v0[3]); w.z = cvt_pk_bf16(v1[0], v1[1]); w.w = cvt_pk_bf16(v1[2], v1[3]);
                    const size_t off = ((((((size_t)(row >> 5) * 8 + u.pn) * 2 + bj) * 8 + ks) * 2 + hi) * 32 + (row & 31)) * 8;
                    *(u32x4*)(O + off) = w; }
        }
    }
};
struct EpiGluI8 {
    static constexpr bool PERM = true, AFTER_DRAIN = false;
    bf16_t* O; const float* bias; const float* rs; const float* cs;
    __device__ __forceinline__ void operator()(const f32x4 (&acc)[2][2][4][2], const Unit& u, int wr, int wc, int fr, int fq) const {
        const int row0 = u.pm * BM + wr * 64 + fr; const int ocol = u.pn * 128 + wc * 32 + 8 * fq; const int brow0 = u.pn * BM + wc * 32 + 8 * fq;
        typedef unsigned u32x2_e __attribute__((ext_vector_type(2)));
#pragma unroll
        for (int n = 0; n < 2; ++n) {
            const f32x4 bl = *(const f32x4*)(bias + ocol + 4 * n), bg = *(const f32x4*)(bias + 1024 + ocol + 4 * n);
            const f32x4 cl = *(const f32x4*)(cs + brow0 + 4 * n), cg = *(const f32x4*)(cs + brow0 + HALF + 4 * n);
#pragma unroll
            for (int ai = 0; ai < 2; ++ai)
#pragma unroll
                for (int m = 0; m < 4; ++m) { const int row = row0 + ai * HALF + m * 16; const float rsv = rs[row];
                    const f32x4 l4 = cvt_i8acc(acc[ai][0][m][n], rsv, cl) + bl, g4 = cvt_i8acc(acc[ai][1][m][n], rsv, cg) + bg;
                    float v[4];
#pragma unroll
                    for (int i = 0; i < 4; ++i) v[i] = l4[i] / (1.f + __expf(-g4[i]));
                    *(u32x2_e*)(O + (size_t)row * 1024 + ocol + 4 * n) = (u32x2_e){cvt_pk_bf16(v[0], v[1]), cvt_pk_bf16(v[2], v[3])}; }
        }
    }
};
struct EpiQkvfI8 {
    static constexpr bool PERM = true, AFTER_DRAIN = false;
    EpiBf16I8 inner; float* logf_t; const float* bias;
    __device__ __forceinline__ void operator()(const f32x4 (&acc)[2][2][4][2], const Unit& u, int wr, int wc, int fr, int fq) const {
        if (u.pn < 12) { inner(acc, u, wr, wc, fr, fq); return; }
        if (wc == 0 && fq < 2) {
            const int row0 = u.pm * BM + wr * 64 + fr;
            const int fbase = u.pn * BM;
            f32x4 cv[2]; cv[0] = *(const f32x4*)(inner.cs + fbase + 8 * fq); cv[1] = *(const f32x4*)(inner.cs + fbase + 8 * fq + 4);
#pragma unroll
            for (int ai = 0; ai < 2; ++ai)
#pragma unroll
                for (int m = 0; m < 4; ++m) { const int row = row0 + ai * HALF + m * 16; const int b = row >> 12, s = row & 4095; const float rsv = inner.rs[row];
#pragma unroll
                    for (int n = 0; n < 2; ++n) { const f32x4 a4 = cvt_i8acc(acc[ai][0][m][n], rsv, cv[n]);
#pragma unroll
                        for (int i = 0; i < 4; ++i) { const int col = 8 * fq + 4 * n + i; const float v = a4[i] + bias[fbase + col];
                            logf_t[((size_t)(b * 16 + col) << 12) + s] = fminf(v, 0.f) - log1pf(__expf(-fabsf(v))); } } }
        }
    }
};
}

__device__ __forceinline__ void transpose_item(const float* W, int K, int ldw, bf16* WT, int k0, int n0, int dst_row0, LAS float* scr, int lane) {
    float tv[32];
#pragma unroll
    for (int i = 0; i < 32; ++i) tv[i] = W[(size_t)(k0 + 2 * i + (lane >> 5)) * ldw + n0 + (lane & 31)];
#pragma unroll
    for (int i = 0; i < 32; ++i) scr[(2 * i + (lane >> 5)) * 33 + (lane & 31)] = tv[i];
    LDS_WAIT(); asm volatile("" ::: "memory");
    const int c = lane & 7;
#pragma unroll
    for (int j = 0; j < 4; ++j) { const int n = (lane >> 3) + 8 * j; const LAS float* s = scr + (8 * c) * 33 + n;
        v4u o; o.x = pk2(s[0 * 33], s[1 * 33]); o.y = pk2(s[2 * 33], s[3 * 33]); o.z = pk2(s[4 * 33], s[5 * 33]); o.w = pk2(s[6 * 33], s[7 * 33]);
        *(GAS v4u*)(WT + (size_t)(dst_row0 + n) * K + k0 + 8 * c) = o; }
    LDS_WAIT(); asm volatile("" ::: "memory");
}

struct RowVec { float v[16]; };
__device__ __forceinline__ void load16f(const float* p, int lane, float* v) {
    const f32x4 a = *(const f32x4*)(p + 8 * lane), b = *(const f32x4*)(p + 8 * lane + 4), c = *(const f32x4*)(p + 512 + 8 * lane), d = *(const f32x4*)(p + 512 + 8 * lane + 4);
#pragma unroll
    for (int i = 0; i < 4; ++i) { v[i] = a[i]; v[4 + i] = b[i]; v[8 + i] = c[i]; v[12 + i] = d[i]; }
}
__device__ __forceinline__ void store16f(float* p, int lane, const float* v) {
    *(f32x4*)(p + 8 * lane) = (f32x4){v[0], v[1], v[2], v[3]}; *(f32x4*)(p + 8 * lane + 4) = (f32x4){v[4], v[5], v[6], v[7]};
    *(f32x4*)(p + 512 + 8 * lane) = (f32x4){v[8], v[9], v[10], v[11]}; *(f32x4*)(p + 512 + 8 * lane + 4) = (f32x4){v[12], v[13], v[14], v[15]};
}
__device__ __forceinline__ void store16bf(bf16* p, int lane, const float* v) {
    v4u a, b; a.x = pk2(v[0], v[1]); a.y = pk2(v[2], v[3]); a.z = pk2(v[4], v[5]); a.w = pk2(v[6], v[7]);
    b.x = pk2(v[8], v[9]); b.y = pk2(v[10], v[11]); b.z = pk2(v[12], v[13]); b.w = pk2(v[14], v[15]);
    *(v4u*)(p + 8 * lane) = a; *(v4u*)(p + 512 + 8 * lane) = b;
}
__device__ __forceinline__ unsigned pack_i8x4(float a, float b, float c, float d) {
    int q0 = __float2int_rn(a), q1 = __float2int_rn(b), q2 = __float2int_rn(c), q3 = __float2int_rn(d);
    q0 = max(-127, min(127, q0)); q1 = max(-127, min(127, q1)); q2 = max(-127, min(127, q2)); q3 = max(-127, min(127, q3));
    return ((unsigned)q0 & 255u) | (((unsigned)q1 & 255u) << 8) | (((unsigned)q2 & 255u) << 16) | (((unsigned)q3 & 255u) << 24);
}
__device__ __forceinline__ void store_row_i8(const float* x, unsigned char* hb8_row, float* hs_ptr, int lane) {
    float am = 0.f;
#pragma unroll
    for (int i = 0; i < 16; ++i) am = fmaxf(am, fabsf(x[i]));
    am = wave_max_nl(am);
    const float sc = (am > 0.f) ? am * (1.f / 127.f) : 1.f, inv = 1.f / sc;
    const unsigned w0 = pack_i8x4(x[0] * inv, x[1] * inv, x[2] * inv, x[3] * inv), w1 = pack_i8x4(x[4] * inv, x[5] * inv, x[6] * inv, x[7] * inv);
    const unsigned w2 = pack_i8x4(x[8] * inv, x[9] * inv, x[10] * inv, x[11] * inv), w3 = pack_i8x4(x[12] * inv, x[13] * inv, x[14] * inv, x[15] * inv);
    typedef unsigned u32x2_t __attribute__((ext_vector_type(2)));
    *(u32x2_t*)(hb8_row + 8 * lane) = (u32x2_t){w0, w1}; *(u32x2_t*)(hb8_row + 512 + 8 * lane) = (u32x2_t){w2, w3};
    if (lane == 0) *hs_ptr = sc;
}
__device__ __forceinline__ void resid_ln_row_pre(float* x, const float* y, const float* modg, const float* lng, const float* lnb,
                                                 float* xout_row, bf16* hb_row, const float* modn, int lane, unsigned char* hb8_row = nullptr, float* hs_ptr = nullptr, bool write_bf = true) {
    float g[16];
    load16f(modg, lane, g);
    float s = 0.f;
#pragma unroll
    for (int i = 0; i < 16; ++i) { x[i] = DN_ALPHA * x[i] + g[i] * y[i]; s += x[i]; }
    const float mean = wave_sum(s) * (1.f / D); float q = 0.f;
#pragma unroll
    for (int i = 0; i < 16; ++i) { x[i] -= mean; q += x[i] * x[i]; }
    const float rstd = 1.f / sqrtf(wave_sum(q) * (1.f / D) + LN_EPS);
    load16f(lng, lane, g);
#pragma unroll
    for (int i = 0; i < 16; ++i) x[i] = x[i] * rstd * g[i];
    load16f(lnb, lane, g);
#pragma unroll
    for (int i = 0; i < 16; ++i) x[i] += g[i];
    store16f(xout_row, lane, x);
    if (modn) {
        load16f(modn + 1024, lane, g);
#pragma unroll
        for (int i = 0; i < 16; ++i) x[i] = x[i] * (1.f + g[i]);
        load16f(modn, lane, g);
#pragma unroll
        for (int i = 0; i < 16; ++i) x[i] += g[i];
        if (write_bf) store16bf(hb_row, lane, x);
        if (hb8_row) store_row_i8(x, hb8_row, hs_ptr, lane);
    }
}
__device__ __forceinline__ void resid_ln_row(const float* xin_row, const float* y, const float* modg  , const float* lng, const float* lnb,
                                             float* xout_row, bf16* hb_row, const float* modn  , int lane) {
    float x[16], g[16];
    load16f(xin_row, lane, x); load16f(modg, lane, g);
    float s = 0.f;
#pragma unroll
    for (int i = 0; i < 16; ++i) { x[i] = DN_ALPHA * x[i] + g[i] * y[i]; s += x[i]; }
    const float mean = wave_sum(s) * (1.f / D); float q = 0.f;
#pragma unroll
    for (int i = 0; i < 16; ++i) { x[i] -= mean; q += x[i] * x[i]; }
    const float rstd = 1.f / sqrtf(wave_sum(q) * (1.f / D) + LN_EPS);
    load16f(lng, lane, g);
#pragma unroll
    for (int i = 0; i < 16; ++i) x[i] = x[i] * rstd * g[i];
    load16f(lnb, lane, g);
#pragma unroll
    for (int i = 0; i < 16; ++i) x[i] += g[i];
    store16f(xout_row, lane, x);
    if (modn) {
        load16f(modn + 1024, lane, g);
#pragma unroll
        for (int i = 0; i < 16; ++i) x[i] = x[i] * (1.f + g[i]);
        load16f(modn, lane, g);
#pragma unroll
        for (int i = 0; i < 16; ++i) x[i] += g[i];
        store16bf(hb_row, lane, x);
    }
}

__device__ __forceinline__ unsigned f2key(float f) { const unsigned u = __float_as_uint(f); return u ^ ((unsigned)((int)u >> 31) | 0x80000000u); }
__device__ __forceinline__ float key2f(unsigned k) { const unsigned u = (k & 0x80000000u) ? (k ^ 0x80000000u) : ~k; return __uint_as_float(u); }
#define CE_DESC(x, y) do { const unsigned mx_ = (x) > (y) ? (x) : (y), mn_ = (x) > (y) ? (y) : (x); (x) = mx_; (y) = mn_; } while (0)
template <int O> __device__ __forceinline__ void sort16_desc(unsigned (&a)[64]) {
    CE_DESC(a[O + 0], a[O + 1]); CE_DESC(a[O + 2], a[O + 3]); CE_DESC(a[O + 0], a[O + 2]); CE_DESC(a[O + 1], a[O + 3]); CE_DESC(a[O + 1], a[O + 2]); CE_DESC(a[O + 4], a[O + 5]);
    CE_DESC(a[O + 6], a[O + 7]); CE_DESC(a[O + 4], a[O + 6]); CE_DESC(a[O + 5], a[O + 7]); CE_DESC(a[O + 5], a[O + 6]); CE_DESC(a[O + 0], a[O + 4]); CE_DESC(a[O + 2], a[O + 6]);
    CE_DESC(a[O + 2], a[O + 4]); CE_DESC(a[O + 1], a[O + 5]); CE_DESC(a[O + 3], a[O + 7]); CE_DESC(a[O + 3], a[O + 5]); CE_DESC(a[O + 1], a[O + 2]); CE_DESC(a[O + 3], a[O + 4]);
    CE_DESC(a[O + 5], a[O + 6]); CE_DESC(a[O + 8], a[O + 9]); CE_DESC(a[O + 10], a[O + 11]); CE_DESC(a[O + 8], a[O + 10]); CE_DESC(a[O + 9], a[O + 11]); CE_DESC(a[O + 9], a[O + 10]);
    CE_DESC(a[O + 12], a[O + 13]); CE_DESC(a[O + 14], a[O + 15]); CE_DESC(a[O + 12], a[O + 14]); CE_DESC(a[O + 13], a[O + 15]); CE_DESC(a[O + 13], a[O + 14]); CE_DESC(a[O + 8], a[O + 12]);
    CE_DESC(a[O + 10], a[O + 14]); CE_DESC(a[O + 10], a[O + 12]); CE_DESC(a[O + 9], a[O + 13]); CE_DESC(a[O + 11], a[O + 15]); CE_DESC(a[O + 11], a[O + 13]); CE_DESC(a[O + 9], a[O + 10]);
    CE_DESC(a[O + 11], a[O + 12]); CE_DESC(a[O + 13], a[O + 14]); CE_DESC(a[O + 0], a[O + 8]); CE_DESC(a[O + 4], a[O + 12]); CE_DESC(a[O + 4], a[O + 8]); CE_DESC(a[O + 2], a[O + 10]);
    CE_DESC(a[O + 6], a[O + 14]); CE_DESC(a[O + 6], a[O + 10]); CE_DESC(a[O + 2], a[O + 4]); CE_DESC(a[O + 6], a[O + 8]); CE_DESC(a[O + 10], a[O + 12]); CE_DESC(a[O + 1], a[O + 9]);
    CE_DESC(a[O + 5], a[O + 13]); CE_DESC(a[O + 5], a[O + 9]); CE_DESC(a[O + 3], a[O + 11]); CE_DESC(a[O + 7], a[O + 15]); CE_DESC(a[O + 7], a[O + 11]); CE_DESC(a[O + 3], a[O + 5]);
    CE_DESC(a[O + 7], a[O + 9]); CE_DESC(a[O + 11], a[O + 13]); CE_DESC(a[O + 1], a[O + 2]); CE_DESC(a[O + 3], a[O + 4]); CE_DESC(a[O + 5], a[O + 6]); CE_DESC(a[O + 7], a[O + 8]);
    CE_DESC(a[O + 9], a[O + 10]); CE_DESC(a[O + 11], a[O + 12]); CE_DESC(a[O + 13], a[O + 14]);
}
template <int O> __device__ __forceinline__ void bmerge16_desc(unsigned (&a)[64]) {
#pragma unroll
    for (int lj = 3; lj >= 0; --lj)
#pragma unroll
        for (int i = 0; i < 16; ++i) { const int j = 1 << lj, l = i ^ j; if (l > i) CE_DESC(a[O + i], a[O + l]); }
}
template <int OA, int OB> __device__ __forceinline__ void topmerge16(unsigned (&a)[64]) {
#pragma unroll
    for (int i = 0; i < 16; ++i) { const unsigned x = a[OA + i], y = a[OB + 15 - i]; a[OA + i] = x > y ? x : y; }
    bmerge16_desc<OA>(a);
}
__device__ __forceinline__ void top16_of_64(unsigned (&a)[64]) {
    sort16_desc<0>(a); sort16_desc<16>(a); sort16_desc<32>(a); sort16_desc<48>(a);
    topmerge16<0, 16>(a); topmerge16<32, 48>(a); topmerge16<0, 32>(a);
}
__host__ __device__ constexpr bool pk_valid(int i, int j) { return (i + 1) * (j + 1) <= 16; }
__host__ __device__ constexpr int pk_pos(int i, int j) { int n = 0; for (int a = 0; a < 16; ++a) for (int b = 0; b < 16; ++b) { if (a == i && b == j) return n; if (pk_valid(a, b)) ++n; } return n; }
static_assert(pk_pos(15, 1) == 50, "50 candidate pairs");

template <int IJ> __device__ __forceinline__ void fill_cand(unsigned (&c)[64], const float (&v1)[16], const float (&v2)[16]) {
    if constexpr (IJ < 256) { constexpr int i = IJ >> 4, j = IJ & 15;
        if constexpr (pk_valid(i, j)) { constexpr int p = pk_pos(i, j); c[p] = (f2key(v1[i] + v2[j]) & ~0xFFu) | (unsigned)(i * 16 + j); }
        fill_cand<IJ + 1>(c, v1, v2); }
}
__device__ __forceinline__ void peer_half_top16(const bf16x8 (&bq)[8], const LAS bf16x8* skf  , int lane, int hi, unsigned (&L)[16]) {
    using attn_body::f32x16;
    f32x16 acc[4]; acc[0] = f32x16{}; acc[1] = f32x16{}; acc[2] = f32x16{}; acc[3] = f32x16{};
#pragma unroll
    for (int ks = 0; ks < 8; ++ks) {
#pragma unroll
        for (int kb = 0; kb < 4; ++kb) { const bf16x8 ak = skf[(kb * 8 + ks) * 64 + lane];
            acc[kb] = __builtin_amdgcn_mfma_f32_32x32x16_bf16(ak, bq[ks], acc[kb], 0, 0, 0); }
    }
    unsigned a[64];
#pragma unroll
    for (int kb = 0; kb < 4; ++kb)
#pragma unroll
        for (int r = 0; r < 16; ++r) a[kb * 16 + r] = (f2key(acc[kb][r]) & ~0x7Fu) | (unsigned)(kb * 32 + (r & 3) + 8 * (r >> 2) + 4 * hi);
    top16_of_64(a);
#pragma unroll
    for (int i = 0; i < 16; ++i) a[16 + i] = (unsigned)__shfl_xor((int)a[i], 32);
    topmerge16<0, 16>(a);
#pragma unroll
    for (int i = 0; i < 16; ++i) L[i] = a[i];
}
__device__ __forceinline__ unsigned byte_lookup(unsigned long long lo, unsigned long long hi8, unsigned i) {
    const unsigned long long s = (i & 8u) ? hi8 : lo; return (unsigned)(s >> ((i & 7u) * 8u)) & 0x7Fu;
}
__device__ __forceinline__ void peer_topk_item(const bf16* PQ, const LAS bf16x8* skf  , unsigned* IDX, float* GATE, int tb, int head, int lane) {
    const int r32 = lane & 31, hi = lane >> 5; const int t0 = tb * 32;
    unsigned L1[16], L2[16];
    bf16x8 bq0[8], bq1[8];
    { const bf16* pr = PQ + ((size_t)(tb * 8 + head) * 2) * 8 * 512 + (size_t)lane * 8;
#pragma unroll
      for (int ks = 0; ks < 8; ++ks) { bq0[ks] = *(const bf16x8*)(pr + ks * 512); bq1[ks] = *(const bf16x8*)(pr + 8 * 512 + ks * 512); } }
    __builtin_amdgcn_sched_barrier(0);
    peer_half_top16(bq0, skf, lane, hi, L1);
    peer_half_top16(bq1, skf + 4 * 8 * 64, lane, hi, L2);
    float v1[16], v2[16]; unsigned long long p1lo = 0, p1hi = 0, p2lo = 0, p2hi = 0;
#pragma unroll
    for (int i = 0; i < 16; ++i) { v1[i] = key2f(L1[i] & ~0x7Fu); v2[i] = key2f(L2[i] & ~0x7Fu);
        const unsigned long long b1 = (unsigned long long)(L1[i] & 0x7Fu) << ((i & 7) * 8), b2 = (unsigned long long)(L2[i] & 0x7Fu) << ((i & 7) * 8);
        if (i < 8) { p1lo |= b1; p2lo |= b2; } else { p1hi |= b1; p2hi |= b2; } }
    unsigned c[64];
    fill_cand<0>(c, v1, v2);
#pragma unroll
    for (int i = 50; i < 64; ++i) c[i] = 0u;
    sort16_desc<0>(c); sort16_desc<16>(c); sort16_desc<32>(c); CE_DESC(c[48], c[49]);
    topmerge16<0, 16>(c); topmerge16<32, 48>(c); topmerge16<0, 32>(c);
    float sc[16], e[16]; unsigned ex[16]; float sum = 0.f;
#pragma unroll
    for (int k = 0; k < 16; ++k) { const unsigned id = c[k] & 0xFFu; sc[k] = key2f(c[k] & ~0xFFu);
        ex[k] = byte_lookup(p1lo, p1hi, id >> 4) * 128u + byte_lookup(p2lo, p2hi, id & 15u); }
#pragma unroll
    for (int k = 0; k < 16; ++k) { e[k] = __expf(sc[k] - sc[0]); sum += e[k]; }
    const float rs = 1.f / sum;
    v4u i0, i1; f32x4 g0, g1;
    i0.x = hi ? ex[8] : ex[0]; i0.y = hi ? ex[9] : ex[1]; i0.z = hi ? ex[10] : ex[2]; i0.w = hi ? ex[11] : ex[3];
    i1.x = hi ? ex[12] : ex[4]; i1.y = hi ? ex[13] : ex[5]; i1.z = hi ? ex[14] : ex[6]; i1.w = hi ? ex[15] : ex[7];
    g0[0] = (hi ? e[8] : e[0]) * rs; g0[1] = (hi ? e[9] : e[1]) * rs; g0[2] = (hi ? e[10] : e[2]) * rs; g0[3] = (hi ? e[11] : e[3]) * rs;
    g1[0] = (hi ? e[12] : e[4]) * rs; g1[1] = (hi ? e[13] : e[5]) * rs; g1[2] = (hi ? e[14] : e[6]) * rs; g1[3] = (hi ? e[15] : e[7]) * rs;
    const size_t o = (size_t)(t0 + r32) * NSEL + head * 16 + hi * 8;
    { v4u pw; pw.x = i0.x | (i0.y << 16); pw.y = i0.z | (i0.w << 16); pw.z = i1.x | (i1.y << 16); pw.w = i1.z | (i1.w << 16);
      *(v4u*)(IDX + (o >> 1)) = pw; }
    *(f32x4*)(GATE + o) = g0; *(f32x4*)(GATE + o + 4) = g1;
}

typedef float f32x2 __attribute__((ext_vector_type(2)));
__device__ __forceinline__ void load16fB(const float* p, int lane, float* v) {
    const f32x4 a = *(const f32x4*)(p + 16 * lane), b = *(const f32x4*)(p + 16 * lane + 4), c = *(const f32x4*)(p + 16 * lane + 8), d = *(const f32x4*)(p + 16 * lane + 12);
#pragma unroll
    for (int i = 0; i < 4; ++i) { v[i] = a[i]; v[4 + i] = b[i]; v[8 + i] = c[i]; v[12 + i] = d[i]; }
}
__device__ __forceinline__ void store16fB(float* p, int lane, const float* v) {
    *(f32x4*)(p + 16 * lane) = (f32x4){v[0], v[1], v[2], v[3]}; *(f32x4*)(p + 16 * lane + 4) = (f32x4){v[4], v[5], v[6], v[7]};
    *(f32x4*)(p + 16 * lane + 8) = (f32x4){v[8], v[9], v[10], v[11]}; *(f32x4*)(p + 16 * lane + 12) = (f32x4){v[12], v[13], v[14], v[15]};
}
__device__ __forceinline__ void store16bfB(bf16* p, int lane, const float* v) {
    v4u a, b; a.x = pk2(v[0], v[1]); a.y = pk2(v[2], v[3]); a.z = pk2(v[4], v[5]); a.w = pk2(v[6], v[7]);
    b.x = pk2(v[8], v[9]); b.y = pk2(v[10], v[11]); b.z = pk2(v[12], v[13]); b.w = pk2(v[14], v[15]);
    *(v4u*)(p + 16 * lane) = a; *(v4u*)(p + 16 * lane + 8) = b;
}
__device__ __forceinline__ void resid_ln_rowB(const float* xin_row, const float* y, const float* modg, const float* lng, const float* lnb,
                                              float* xout_row, bf16* hb_row, const float* modn, int lane) {
    float x[16], g[16];
    load16fB(xin_row, lane, x); load16fB(modg, lane, g);
    float s = 0.f;
#pragma unroll
    for (int i = 0; i < 16; ++i) { x[i] = DN_ALPHA * x[i] + g[i] * y[i]; s += x[i]; }
    const float mean = wave_sum(s) * (1.f / D); float q = 0.f;
#pragma unroll
    for (int i = 0; i < 16; ++i) { x[i] -= mean; q += x[i] * x[i]; }
    const float rstd = 1.f / sqrtf(wave_sum(q) * (1.f / D) + LN_EPS);
    load16fB(lng, lane, g);
#pragma unroll
    for (int i = 0; i < 16; ++i) x[i] = x[i] * rstd * g[i];
    load16fB(lnb, lane, g);
#pragma unroll
    for (int i = 0; i < 16; ++i) x[i] += g[i];
    store16fB(xout_row, lane, x);
    if (modn) {
        load16fB(modn + 1024, lane, g);
#pragma unroll
        for (int i = 0; i < 16; ++i) x[i] = x[i] * (1.f + g[i]);
        load16fB(modn, lane, g);
#pragma unroll
        for (int i = 0; i < 16; ++i) x[i] += g[i];
        store16bfB(hb_row, lane, x);
    }
}
__device__ __forceinline__ float dot16_fp8(const v4u w, const f32x2 (&h)[8]) {
    f32x2 acc = {0.f, 0.f};
    acc = __builtin_elementwise_fma(__builtin_amdgcn_cvt_pk_f32_fp8(w.x, false), h[0], acc); acc = __builtin_elementwise_fma(__builtin_amdgcn_cvt_pk_f32_fp8(w.x, true), h[1], acc);
    acc = __builtin_elementwise_fma(__builtin_amdgcn_cvt_pk_f32_fp8(w.y, false), h[2], acc); acc = __builtin_elementwise_fma(__builtin_amdgcn_cvt_pk_f32_fp8(w.y, true), h[3], acc);
    acc = __builtin_elementwise_fma(__builtin_amdgcn_cvt_pk_f32_fp8(w.z, false), h[4], acc); acc = __builtin_elementwise_fma(__builtin_amdgcn_cvt_pk_f32_fp8(w.z, true), h[5], acc);
    acc = __builtin_elementwise_fma(__builtin_amdgcn_cvt_pk_f32_fp8(w.w, false), h[6], acc); acc = __builtin_elementwise_fma(__builtin_amdgcn_cvt_pk_f32_fp8(w.w, true), h[7], acc);
    return acc.x + acc.y;
}
__device__ __forceinline__ void axpy16_fp8(f32x2 (&o)[8], float a, const v4u w) {
    const f32x2 a2 = {a, a};
    o[0] = __builtin_elementwise_fma(__builtin_amdgcn_cvt_pk_f32_fp8(w.x, false), a2, o[0]); o[1] = __builtin_elementwise_fma(__builtin_amdgcn_cvt_pk_f32_fp8(w.x, true), a2, o[1]);
    o[2] = __builtin_elementwise_fma(__builtin_amdgcn_cvt_pk_f32_fp8(w.y, false), a2, o[2]); o[3] = __builtin_elementwise_fma(__builtin_amdgcn_cvt_pk_f32_fp8(w.y, true), a2, o[3]);
    o[4] = __builtin_elementwise_fma(__builtin_amdgcn_cvt_pk_f32_fp8(w.z, false), a2, o[4]); o[5] = __builtin_elementwise_fma(__builtin_amdgcn_cvt_pk_f32_fp8(w.z, true), a2, o[5]);
    o[6] = __builtin_elementwise_fma(__builtin_amdgcn_cvt_pk_f32_fp8(w.w, false), a2, o[6]); o[7] = __builtin_elementwise_fma(__builtin_amdgcn_cvt_pk_f32_fp8(w.w, true), a2, o[7]);
}
#define SCHED_FENCE() __builtin_amdgcn_sched_barrier(0)
template <bool DRY> __device__ __forceinline__ void peer_gather_wave(int tok0, const bf16* HBp, const unsigned* IDXp, const float* GATEp, const unsigned char* U8, const unsigned char* V8,
                                                 const float* SU, const float* SV, float* Xp, bf16* HBo, const float* prm, bool has_next, int lane) {
    const int hi = lane >> 5;
    const int e_lane = (lane & 7) + 8 * hi;
    const unsigned loff = 16u * (unsigned)lane;
    unsigned idx_lo = IDXp[(size_t)tok0 * NSEL + lane], idx_hi = IDXp[(size_t)tok0 * NSEL + 64 + lane];
    v4u wu[16], wv[16];
#pragma unroll
    for (int e = 0; e < 16; ++e) { const unsigned eid = (unsigned)__builtin_amdgcn_readlane((int)idx_lo, e); wu[e] = *(const v4u*)(U8 + (size_t)eid * D + loff); }
#pragma unroll 1
    for (int t = 0; t < 16; ++t) {
        const int tok = tok0 + t;
        const float su_lo = SU[idx_lo], su_hi = SU[idx_hi], sv_lo = SV[idx_lo], sv_hi = SV[idx_hi];
        unsigned nidx_lo = idx_lo, nidx_hi = idx_hi;
        if (t < 15) { nidx_lo = IDXp[(size_t)(tok + 1) * NSEL + lane]; nidx_hi = IDXp[(size_t)(tok + 1) * NSEL + 64 + lane]; }
        f32x2 h[8];
        { const v4u h0 = *(const v4u*)(HBp + (size_t)tok * D + loff), h1 = *(const v4u*)(HBp + (size_t)tok * D + loff + 8);
          h[0] = (f32x2){bf_lo(h0.x), bf_hi(h0.x)}; h[1] = (f32x2){bf_lo(h0.y), bf_hi(h0.y)}; h[2] = (f32x2){bf_lo(h0.z), bf_hi(h0.z)}; h[3] = (f32x2){bf_lo(h0.w), bf_hi(h0.w)};
          h[4] = (f32x2){bf_lo(h1.x), bf_hi(h1.x)}; h[5] = (f32x2){bf_lo(h1.y), bf_hi(h1.y)}; h[6] = (f32x2){bf_lo(h1.z), bf_hi(h1.z)}; h[7] = (f32x2){bf_lo(h1.w), bf_hi(h1.w)}; }
        float x[16]; load16fB(Xp + (size_t)tok * D, lane, x);
        f32x2 o[8];
#pragma unroll
        for (int i = 0; i < 8; ++i) o[i] = (f32x2){0.f, 0.f};
#pragma unroll 1
        for (int b = 0; b < 8; ++b) {
            const unsigned idxr = (b < 4) ? idx_lo : idx_hi; const int lb = (b & 3) * 16;
#pragma unroll
            for (int e = 0; e < 16; ++e) { const unsigned eid = (unsigned)__builtin_amdgcn_readlane((int)idxr, lb + e); wv[e] = *(const v4u*)(V8 + (size_t)eid * D + loff); }
            const float gt = GATEp[(size_t)tok * NSEL + b * 16 + e_lane];
            SCHED_FENCE();
            float p[16];
#pragma unroll
            for (int e = 0; e < 16; ++e) p[e] = dot16_fp8(wu[e], h);
            SCHED_FENCE();
            { const int nb = (b + 1) & 7; const unsigned nidxr = (b == 7) ? nidx_lo : ((nb < 4) ? idx_lo : idx_hi); const int nlb = (nb & 3) * 16;
#pragma unroll
              for (int e = 0; e < 16; ++e) { const unsigned eid = (unsigned)__builtin_amdgcn_readlane((int)nidxr, nlb + e); wu[e] = *(const v4u*)(U8 + (size_t)eid * D + loff); } }
            SCHED_FENCE();
            float q8[8];
#pragma unroll
            for (int k = 0; k < 8; ++k) { auto r = __builtin_amdgcn_permlane32_swap(__float_as_uint(p[k]), __float_as_uint(p[k + 8]), false, false);
                float v = __uint_as_float(r[0]) + __uint_as_float(r[1]);
                v += dpp_f<0x128>(v); v += dpp_f<0x124>(v); v += dpp_f<0x122>(v); v += dpp_f<0x121>(v);
                q8[k] = v; }
#pragma unroll
            for (int k = 0; k < 8; ++k) q8[k] += __shfl_xor(q8[k], 16);
            const int ks = lane & 7;
            float tot = q8[0];
#pragma unroll
            for (int k = 1; k < 8; ++k) tot = (ks == k) ? q8[k] : tot;
            const float sgu = __shfl((b < 4) ? su_lo : su_hi, lb + e_lane), sgv = __shfl((b < 4) ? sv_lo : sv_hi, lb + e_lane);
            tot *= sgu;
            const float act = 0.5f * tot * (1.f + erff(tot * 0.70710678118654752f)) * gt * sgv;
            SCHED_FENCE();
#pragma unroll
            for (int e = 0; e < 16; ++e) {
                const float a = __uint_as_float((unsigned)__builtin_amdgcn_readlane((int)__float_as_uint(act), (e & 7) + 32 * (e >> 3)));
                axpy16_fp8(o, a, wv[e]);
            }
            SCHED_FENCE();
        }
        float s = 0.f;
#pragma unroll
        for (int i = 0; i < 16; ++i) { const float y = (i & 1) ? o[i >> 1].y : o[i >> 1].x; x[i] = DN_ALPHA * x[i] + prm[loff + i] * y; s += x[i]; }
        const float mean = wave_sum(s) * (1.f / D); float q = 0.f;
#pragma unroll
        for (int i = 0; i < 16; ++i) { x[i] -= mean; q += x[i] * x[i]; }
        const float rstd = 1.f / sqrtf(wave_sum(q) * (1.f / D) + LN_EPS);
#pragma unroll
        for (int i = 0; i < 16; ++i) x[i] = x[i] * rstd * prm[1024 + loff + i] + prm[2048 + loff + i];
        if (DRY) { _Pragma("unroll") for (int i = 0; i < 16; ++i) asm volatile("" :: "v"(x[i])); }
        else store16fB(Xp + (size_t)tok * D, lane, x);
        if (has_next && !DRY) {
#pragma unroll
            for (int i = 0; i < 16; ++i) x[i] = x[i] * (1.f + prm[4096 + loff + i]) + prm[3072 + loff + i];
            store16bfB(HBo + (size_t)tok * D, lane, x);
        }
        idx_lo = nidx_lo; idx_hi = nidx_hi;
    }
}

__device__ __forceinline__ float red8(float v) {
    v += dpp_f<0x141>(v);
    v += dpp_f<0xB1>(v);
    v += dpp_f<0x4E>(v);
    return v;
}
__device__ __forceinline__ void unpack_h16(const v4u h0, const v4u h1, f32x2 (&h)[8]) {
    h[0] = (f32x2){bf_lo(h0.x), bf_hi(h0.x)}; h[1] = (f32x2){bf_lo(h0.y), bf_hi(h0.y)}; h[2] = (f32x2){bf_lo(h0.z), bf_hi(h0.z)}; h[3] = (f32x2){bf_lo(h0.w), bf_hi(h0.w)};
    h[4] = (f32x2){bf_lo(h1.x), bf_hi(h1.x)}; h[5] = (f32x2){bf_lo(h1.y), bf_hi(h1.y)}; h[6] = (f32x2){bf_lo(h1.z), bf_hi(h1.z)}; h[7] = (f32x2){bf_lo(h1.w), bf_hi(h1.w)};
}
__device__ __forceinline__ int red8i(int v) {
    v += __builtin_amdgcn_update_dpp(0, v, 0x141, 0xF, 0xF, true);
    v += __builtin_amdgcn_update_dpp(0, v, 0xB1, 0xF, 0xF, true);
    v += __builtin_amdgcn_update_dpp(0, v, 0x4E, 0xF, 0xF, true);
    return v;
}
__device__ __forceinline__ void peer_pass_u(int x, int t0, int NT, const unsigned char* H8, const unsigned* IDXp, const unsigned char* U8, float* PD, int lane) {
    const int g = lane >> 3, sub = lane & 7; const unsigned coff = 128u * (unsigned)x + 16u * (unsigned)sub;
    const unsigned char* U8s = U8 + (size_t)x * (NEXP * 128) + 16 * sub;
    v4u wuA[16], wuB[16]; v4u hA, hB;
    unsigned ia_lo, ia_hi, ib_lo, ib_hi, ic_lo, ic_hi;
#define PU_META(lo, hi, tok) do { lo = IDXp[(size_t)(tok) * 64 + lane]; hi = 0u; } while (0)
#define PU_ISSUE(W, H, lo, hi, tok) do { _Pragma("unroll") for (int i = 0; i < 16; ++i) { const unsigned ew_ = (unsigned)__shfl((int)lo, 4 * i + (g >> 1)); const unsigned eid = (g & 1) ? (ew_ >> 16) : (ew_ & 0xFFFFu); \
            W[i] = *(const v4u*)(U8s + (size_t)eid * 128); } \
        H = *(const v4u*)(H8 + (size_t)(tok) * D + coff); } while (0)
#define PU_COMPUTE(W, H, tok) do { int vlo = 0, vhi = 0; \
        _Pragma("unroll") for (int i = 0; i < 16; ++i) { int d = __builtin_amdgcn_sdot4((int)W[i].x, (int)H.x, 0, false); d = __builtin_amdgcn_sdot4((int)W[i].y, (int)H.y, d, false); \
            d = __builtin_amdgcn_sdot4((int)W[i].z, (int)H.z, d, false); d = __builtin_amdgcn_sdot4((int)W[i].w, (int)H.w, d, false); \
            const int tot = red8i(d); if (i < 8) vlo = (sub == i) ? tot : vlo; else vhi = (sub == i - 8) ? tot : vhi; } \
        ((unsigned*)PD)[((size_t)x * M + (tok)) * 64 + 8 * sub + g] = pk2((float)vlo, (float)vhi); } while (0)
    PU_META(ia_lo, ia_hi, t0); PU_META(ib_lo, ib_hi, t0 + 1);
    PU_ISSUE(wuA, hA, ia_lo, ia_hi, t0);
#pragma unroll 1
    for (int n = 0; n < NT; n += 2) { const int tok = t0 + n;
        PU_ISSUE(wuB, hB, ib_lo, ib_hi, tok + 1);
        if (n + 2 < NT) PU_META(ic_lo, ic_hi, tok + 2);
        SCHED_FENCE();
        PU_COMPUTE(wuA, hA, tok);
        SCHED_FENCE();
        if (n + 2 < NT) { ia_lo = ic_lo; ia_hi = ic_hi; PU_ISSUE(wuA, hA, ia_lo, ia_hi, tok + 2); PU_META(ic_lo, ic_hi, tok + 3); }
        SCHED_FENCE();
        PU_COMPUTE(wuB, hB, tok + 1);
        SCHED_FENCE();
        ib_lo = ic_lo; ib_hi = ic_hi;
    }
#undef PU_META
#undef PU_ISSUE
#undef PU_COMPUTE
}
__device__ __forceinline__ void peer_pass_a(int t0, int NT, const unsigned* IDXp, float* GATEp, const float* SU, const float* SV, const float* PD, const float* HS, int lane) {
#pragma unroll 1
    for (int n = 0; n < NT; n += 2) {
        float s[2][2], gt[2][2], su[2][2], sv[2][2];
#pragma unroll
        for (int q = 0; q < 2; ++q) { const size_t ro = (size_t)(t0 + n + q) * NSEL;
            const unsigned w0_ = IDXp[(ro >> 1) + (lane >> 1)], w1_ = IDXp[(ro >> 1) + 32 + (lane >> 1)];
            const unsigned i0 = (lane & 1) ? (w0_ >> 16) : (w0_ & 0xFFFFu), i1 = (lane & 1) ? (w1_ >> 16) : (w1_ & 0xFFFFu);
            gt[q][0] = GATEp[ro + lane]; gt[q][1] = GATEp[ro + 64 + lane];
            su[q][0] = SU[i0]; su[q][1] = SU[i1]; sv[q][0] = SV[i0]; sv[q][1] = SV[i1];
            float a0 = 0.f, a1 = 0.f;
#pragma unroll
            for (int xx = 0; xx < 8; ++xx) { const unsigned pw = ((const unsigned*)PD)[((size_t)xx * M + (t0 + n + q)) * 64 + lane]; a0 += bf_lo(pw); a1 += bf_hi(pw); }
            s[q][0] = a0; s[q][1] = a1; }
#pragma unroll
        for (int q = 0; q < 2; ++q) { const size_t ro = (size_t)(t0 + n + q) * NSEL;
            const float hs = HS[t0 + n + q];
#pragma unroll
            for (int k = 0; k < 2; ++k) { const float t = s[q][k] * su[q][k] * hs;
                GATEp[ro + 64 * k + lane] = 0.5f * t * (1.f + erff(t * 0.70710678118654752f)) * gt[q][k] * sv[q][k]; } }
    }
}
__device__ __forceinline__ void peer_pass_v(int x, int t0, int NT, const unsigned* IDXp, const float* Ap, const unsigned char* V8, bf16* YS, int lane) {
    const int g = lane >> 3, sub = lane & 7, hi = lane >> 5; const unsigned coff = 128u * (unsigned)x + 16u * (unsigned)sub;
    const unsigned char* V8s = V8 + (size_t)x * (NEXP * 128) + 16 * sub;
    v4u wvA[16], wvB[16];
    unsigned ia_lo, ia_hi, ib_lo, ib_hi, ic_lo, ic_hi; float aa_lo, aa_hi, ab_lo, ab_hi, ac_lo, ac_hi;
#define PV_META(lo, hi, alo, ahi, tok) do { lo = IDXp[(size_t)(tok) * 64 + lane]; hi = 0u; alo = Ap[(size_t)(tok) * NSEL + lane]; ahi = Ap[(size_t)(tok) * NSEL + 64 + lane]; } while (0)
#define PV_ISSUE(W, lo, hi) do { _Pragma("unroll") for (int i = 0; i < 16; ++i) { const unsigned ew_ = (unsigned)__shfl((int)lo, 4 * i + (g >> 1)); const unsigned eid = (g & 1) ? (ew_ >> 16) : (ew_ & 0xFFFFu); \
            W[i] = *(const v4u*)(V8s + (size_t)eid * 128); } } while (0)
#define PV_COMPUTE(W, alo, ahi, tok) do { float av[16]; _Pragma("unroll") for (int i = 0; i < 16; ++i) av[i] = __shfl(i < 8 ? alo : ahi, 8 * (i & 7) + g); \
        f32x2 o[8]; _Pragma("unroll") for (int i = 0; i < 8; ++i) o[i] = (f32x2){0.f, 0.f}; \
        _Pragma("unroll") for (int i = 0; i < 16; ++i) axpy16_fp8(o, av[i], W[i]); \
        float r8[8]; \
        _Pragma("unroll") for (int c = 0; c < 8; ++c) { const float lo_ = (c & 1) ? o[c >> 1].y : o[c >> 1].x, hh_ = (c & 1) ? o[4 + (c >> 1)].y : o[4 + (c >> 1)].x; \
            auto rr = __builtin_amdgcn_permlane32_swap(__float_as_uint(lo_), __float_as_uint(hh_), false, false); \
            float v = __uint_as_float(rr[0]) + __uint_as_float(rr[1]); v += dpp_f<0x128>(v); r8[c] = v; } \
        _Pragma("unroll") for (int c = 0; c < 8; ++c) r8[c] += __shfl_xor(r8[c], 16); \
        if ((lane & 0x18) == 0) { v4u w; w.x = pk2(r8[0], r8[1]); w.y = pk2(r8[2], r8[3]); w.z = pk2(r8[4], r8[5]); w.w = pk2(r8[6], r8[7]); \
            *(v4u*)(YS + (size_t)(tok) * D + coff + 8 * hi) = w; } } while (0)
    PV_META(ia_lo, ia_hi, aa_lo, aa_hi, t0); PV_META(ib_lo, ib_hi, ab_lo, ab_hi, t0 + 1);
    PV_ISSUE(wvA, ia_lo, ia_hi);
#pragma unroll 1
    for (int n = 0; n < NT; n += 2) { const int tok = t0 + n;
        PV_ISSUE(wvB, ib_lo, ib_hi);
        if (n + 2 < NT) PV_META(ic_lo, ic_hi, ac_lo, ac_hi, tok + 2);
        SCHED_FENCE();
        PV_COMPUTE(wvA, aa_lo, aa_hi, tok);
        SCHED_FENCE();
        if (n + 2 < NT) { ia_lo = ic_lo; ia_hi = ic_hi; aa_lo = ac_lo; aa_hi = ac_hi; PV_ISSUE(wvA, ia_lo, ia_hi); PV_META(ic_lo, ic_hi, ac_lo, ac_hi, tok + 3); }
        SCHED_FENCE();
        PV_COMPUTE(wvB, ab_lo, ab_hi, tok + 1);
        SCHED_FENCE();
        ib_lo = ic_lo; ib_hi = ic_hi; ab_lo = ac_lo; ab_hi = ac_hi;
    }
#undef PV_META
#undef PV_ISSUE
#undef PV_COMPUTE
}

#define KINRAW(k) (((const unsigned long long volatile __attribute__((address_space(4)))*)__builtin_amdgcn_kernarg_segment_ptr())[k])
#define KIN(k) ((const float*)(const GAS float*)KINRAW(k))
__global__ void __launch_bounds__(NTHR, 2) trunk_fwd(Args args) {
    extern __shared__ __attribute__((aligned(16))) unsigned char lds[];
    LAS unsigned char* ldsl = (LAS unsigned char*)lds;
    volatile LAS unsigned* MISC = (volatile LAS unsigned*)(ldsl + MISC_OFF);
    const int G = gridDim.x; const int bx = blockIdx.x; const int vcu = (G % 8 == 0) ? (bx % 8) * (G / 8) + bx / 8 : bx;
    const int NGW = G * NWAVES;
#define PHASE_IDS int tid = threadIdx.x; asm volatile("" : "+v"(tid)); const int lane = tid & 63, wave = __builtin_amdgcn_readfirstlane(tid >> 6); const int gw = vcu * NWAVES + wave; (void)gw; (void)lane;
    gu32* ctl = (gu32*)((GAS unsigned char*)KINRAW(28) + WS_CTL);
    for (int u = threadIdx.x; u < (LDS_BYTES - LDSCTL_OFF) / 4; u += NTHR) ((LAS unsigned*)(ldsl + LDSCTL_OFF))[u] = 0u;
    __syncthreads();
    XcdBarrier bar = xcd_barrier_post((unsigned*)(ctl + CW_BAR), MISC + 8);
#define GRID_BAR() xcd_barrier(bar)

#define x_in KIN(0)
#define c_in KIN(1)
#define ada_mix_w KIN(2)
#define ada_mix_b KIN(3)
#define ln_mix_g KIN(4)
#define ln_mix_b KIN(5)
#define conv_in_w KIN(6)
#define conv_in_b KIN(7)
#define conv_dw_w KIN(8)
#define conv_dw_b KIN(9)
#define conv_ln_g KIN(10)
#define conv_ln_b KIN(11)
#define conv_out_w KIN(12)
#define conv_out_b KIN(13)
#define attn_in_w KIN(14)
#define attn_in_b KIN(15)
#define attn_out_w KIN(16)
#define attn_out_b KIN(17)
#define ada_ffn_w KIN(18)
#define ada_ffn_b KIN(19)
#define ln_ffn_g KIN(20)
#define ln_ffn_b KIN(21)
#define peer_query_w KIN(22)
#define peer_sk1 KIN(23)
#define peer_sk2 KIN(24)
#define peer_u KIN(25)
#define peer_v KIN(26)
#define X ((float*)(GAS float*)KINRAW(27))
#define WSP ((unsigned char*)(GAS unsigned char*)KINRAW(28))
#define MOD ((float*)(WSP + WS_MOD))
#define SKB ((bf16*)(WSP + WS_SKB))
#define LOGF ((float*)(WSP + WS_LOGF))
#define WCI ((bf16*)(WSP + WS_WCI))
#define WCO ((bf16*)(WSP + WS_WCO))
#define WAI ((bf16*)(WSP + WS_WAI))
#define WAO ((bf16*)(WSP + WS_WAO))
#define WPQ ((bf16*)(WSP + WS_WPQ))
#define EXP8 ((unsigned char*)(WSP + WS_EXP))
#define SCL ((float*)(WSP + WS_SC))
#define HB ((bf16*)(WSP + WS_HB))
#define BIG0 ((bf16*)(WSP + WS_BIG))
#define BIG1 ((bf16*)(WSP + WS_BIG + 64 * MiB))
#define BIG2 ((bf16*)(WSP + WS_BIG + 128 * MiB))
#define IDX ((unsigned*)(WSP + WS_IDX))
#define GATE ((float*)(WSP + WS_GATE))
#define HB8 ((unsigned char*)(WSP + WS_HB8))
#define HSC ((float*)(WSP + WS_HS))
#define WCI8 ((unsigned char*)(WSP + WS_WCI8))
#define WAI8 ((unsigned char*)(WSP + WS_WAI8))
#define WPQ8 ((unsigned char*)(WSP + WS_WPQ8))
#define WCO8 ((unsigned char*)(WSP + WS_WCO8))
#define WSC ((float*)(WSP + WS_WSC))

    { PHASE_IDS
        LAS float* scr = (LAS float*)(ldsl + RING_OFF + wave * 16384);
        constexpr int I_CI = 16 * 64, I_CO = 16 * 32, I_AI = 16 * 96, I_AO = 16 * 32, I_PQ = 16 * 64;
        constexpr int NIT = I_CI + I_CO + I_AI + I_AO + 2 * I_PQ;
        for (int it = gw; it < NIT; it += NGW) {
            int r = it;
            if (r < I_CI) { const int kb = r / 64, nb = r % 64, n0 = 32 * nb;
                const int dst = (n0 < 1024) ? (n0 / 128) * 256 + (n0 % 128) : ((n0 - 1024) / 128) * 256 + 128 + ((n0 - 1024) % 128);
                transpose_item(conv_in_w, 1024, 2048, WCI, 64 * kb, n0, dst, scr, lane); continue; } r -= I_CI;
            if (r < I_CO) { const int kb = r / 32, nb = r % 32; transpose_item(conv_out_w, 1024, 1024, WCO, 64 * kb, 32 * nb, 32 * nb, scr, lane); continue; } r -= I_CO;
            if (r < I_AI) { const int kb = r / 96, nb = r % 96; transpose_item(attn_in_w, 1024, NAI, WAI, 64 * kb, 32 * nb, 32 * nb, scr, lane); continue; } r -= I_AI;
            if (r < I_AO) { const int kb = r / 32, nb = r % 32; transpose_item(attn_out_w, 1024, 1024, WAO, 64 * kb, 32 * nb, 32 * nb, scr, lane); continue; } r -= I_AO;
            { const int l = r / I_PQ; r -= l * I_PQ; const int kb = r / 64, nb = r % 64;
              transpose_item(peer_query_w + (size_t)l * 1024 * 2048, 1024, 2048, WPQ + (size_t)l * 2048 * 1024, 64 * kb, 32 * nb, 32 * nb, scr, lane); }
        }
        const int gt = vcu * NTHR + tid, NGT = G * NTHR;
        for (int e = gt; e < 256 * 1024; e += NGT) { const int r = e >> 10, k = e & 1023;
            WAI[(size_t)(3072 + r) * 1024 + k] = (r < 16) ? (bf16)f2bf(attn_in_w[(size_t)k * NAI + 3072 + r]) : (bf16)0; }
        for (int e = gt; e < 2 * 2 * 16384; e += NGT) { const int l = e >> 15, hf = (e >> 14) & 1, i = e & 16383;
            SKB[e] = (bf16)f2bf((hf ? peer_sk2 : peer_sk1)[(size_t)l * 16384 + i]); }
        for (int row0 = gw * 4; row0 < 4 * NEXP; row0 += NGW * 4) {
            float v[4][16];
#pragma unroll
            for (int q = 0; q < 4; ++q) { const int row = row0 + q, t = row >> 14, r = row & (NEXP - 1);
                load16fB(((t & 1) ? peer_v : peer_u) + ((size_t)(t >> 1) * NEXP + r) * D, lane, v[q]); }
#pragma unroll
            for (int q = 0; q < 4; ++q) { const int row = row0 + q;
                float am = 0.f;
#pragma unroll
                for (int i = 0; i < 16; ++i) am = fmaxf(am, fabsf(v[q][i]));
#pragma unroll
                for (int o = 1; o < 64; o <<= 1) am = fmaxf(am, __shfl_xor(am, o));
                const bool isv = ((row >> 14) & 1) != 0;
                const float sc = (am > 0.f) ? am * (isv ? (1.f / 448.f) : (1.f / 127.f)) : 1.f, inv = 1.f / sc;
                v4u w; int pk;
                if (isv) {
                pk = 0; pk = __builtin_amdgcn_cvt_pk_fp8_f32(v[q][0] * inv, v[q][1] * inv, pk, false); pk = __builtin_amdgcn_cvt_pk_fp8_f32(v[q][2] * inv, v[q][3] * inv, pk, true); w.x = (unsigned)pk;
                pk = 0; pk = __builtin_amdgcn_cvt_pk_fp8_f32(v[q][4] * inv, v[q][5] * inv, pk, false); pk = __builtin_amdgcn_cvt_pk_fp8_f32(v[q][6] * inv, v[q][7] * inv, pk, true); w.y = (unsigned)pk;
                pk = 0; pk = __builtin_amdgcn_cvt_pk_fp8_f32(v[q][8] * inv, v[q][9] * inv, pk, false); pk = __builtin_amdgcn_cvt_pk_fp8_f32(v[q][10] * inv, v[q][11] * inv, pk, true); w.z = (unsigned)pk;
                pk = 0; pk = __builtin_amdgcn_cvt_pk_fp8_f32(v[q][12] * inv, v[q][13] * inv, pk, false); pk = __builtin_amdgcn_cvt_pk_fp8_f32(v[q][14] * inv, v[q][15] * inv, pk, true); w.w = (unsigned)pk;
                } else {
                w.x = pack_i8x4(v[q][0] * inv, v[q][1] * inv, v[q][2] * inv, v[q][3] * inv); w.y = pack_i8x4(v[q][4] * inv, v[q][5] * inv, v[q][6] * inv, v[q][7] * inv);
                w.z = pack_i8x4(v[q][8] * inv, v[q][9] * inv, v[q][10] * inv, v[q][11] * inv); w.w = pack_i8x4(v[q][12] * inv, v[q][13] * inv, v[q][14] * inv, v[q][15] * inv);
                }
                *(v4u*)(EXP8 + (size_t)(row >> 14) * NEXP * D + (size_t)(lane >> 3) * (NEXP * 128) + (size_t)(row & (NEXP - 1)) * 128 + 16 * (lane & 7)) = w;
                if (lane == 0) SCL[row] = sc; } }
        for (int it = bx; it < 4 * 6 * 32; it += G) { const int s = it / 192, rem = it % 192, jb = rem / 32, ksp = rem % 32; const int j = jb * 512 + tid;
            const float* W = ((s & 1) ? ada_ffn_w : ada_mix_w) + (size_t)(s >> 1) * 1024 * 3072; const float* bs = ((s & 1) ? ada_ffn_b : ada_mix_b) + (s >> 1) * 3072;
            float a[8];
#pragma unroll
            for (int b = 0; b < 8; ++b) a[b] = 0.f;
            for (int k = ksp * 32; k < ksp * 32 + 32; ++k) { const float w = W[(size_t)k * 3072 + j];
#pragma unroll
                for (int b = 0; b < 8; ++b) { const float cv = c_in[b * 1024 + k]; a[b] += (cv / (1.f + __expf(-cv))) * w; } }
            const float bj = (ksp == 0) ? bs[j] : 0.f;
#pragma unroll
            for (int b = 0; b < 8; ++b) atomicAdd(MOD + ((size_t)s * 8 + b) * 3072 + j, a[b] + bj); }
    }
    GRID_BAR();
    { PHASE_IDS
      const float* mod = MOD + (size_t)(0 * 8 + ((gw * 16) >> 12)) * 3072;
      float sc1[16], sh[16]; load16f(mod + 1024, lane, sc1); load16f(mod, lane, sh);
      float xn[16]; load16f(x_in + (size_t)(gw * 16) * D, lane, xn);
      for (int r = 0; r < 16; ++r) { const int m = gw * 16 + r;
        float x[16];
#pragma unroll
        for (int i = 0; i < 16; ++i) x[i] = xn[i];
        if (r < 15) load16f(x_in + (size_t)(m + 1) * D, lane, xn);
#pragma unroll
        for (int i = 0; i < 16; ++i) x[i] = x[i] * (1.f + sc1[i]) + sh[i];
        store_row_i8(x, HB8 + (size_t)m * D, HSC + m, lane); }
      for (int row = gw; row < 2048 + NAI_PAD + 4096 + 1024; row += NGW) { const bool ci = row < 2048, co = row >= 2048 + NAI_PAD + 4096, pq = !co && row >= 2048 + NAI_PAD;
          const int r = ci ? row : (co ? row - 2048 - NAI_PAD - 4096 : (pq ? row - 2048 - NAI_PAD : row - 2048));
          const bf16* src = (ci ? WCI : (co ? WCO : (pq ? WPQ : WAI))) + (size_t)r * D + 16 * lane;
          const v4u a0 = *(const v4u*)src, a1 = *(const v4u*)(src + 8);
          float v[16];
          v[0] = bf_lo(a0.x); v[1] = bf_hi(a0.x); v[2] = bf_lo(a0.y); v[3] = bf_hi(a0.y); v[4] = bf_lo(a0.z); v[5] = bf_hi(a0.z); v[6] = bf_lo(a0.w); v[7] = bf_hi(a0.w);
          v[8] = bf_lo(a1.x); v[9] = bf_hi(a1.x); v[10] = bf_lo(a1.y); v[11] = bf_hi(a1.y); v[12] = bf_lo(a1.z); v[13] = bf_hi(a1.z); v[14] = bf_lo(a1.w); v[15] = bf_hi(a1.w);
          float am = 0.f;
#pragma unroll
          for (int i = 0; i < 16; ++i) am = fmaxf(am, fabsf(v[i]));
          am = wave_max_nl(am);
          const float sc = (am > 0.f) ? am * (1.f / 127.f) : 1.f, inv = 1.f / sc;
          v4u w; w.x = pack_i8x4(v[0] * inv, v[1] * inv, v[2] * inv, v[3] * inv); w.y = pack_i8x4(v[4] * inv, v[5] * inv, v[6] * inv, v[7] * inv);
          w.z = pack_i8x4(v[8] * inv, v[9] * inv, v[10] * inv, v[11] * inv); w.w = pack_i8x4(v[12] * inv, v[13] * inv, v[14] * inv, v[15] * inv);
          *(v4u*)((ci ? WCI8 : (co ? WCO8 : (pq ? WPQ8 : WAI8))) + (size_t)r * D + 16 * lane) = w;
          if (lane == 0) WSC[row] = sc; } }
    GRID_BAR();

    if (PHM & 1) { pg8::Gemm g{(const bf16*)HB8, (const bf16*)WCI8, M, 2048, D / 2}; pg8::StaticOrder S; S.init(M, 2048, G, bx);
      pg8::EpiGluI8 E{BIG0, conv_in_b, HSC, WSC};
      for (int rep_ = 0; rep_ < NREP_GEMM; ++rep_) {
      pg8::gemm_phase<pg8::EpiGluI8, pg8::StaticOrder, PG8_ALIGN, PG8_SP2, true>(ldsl + RING_OFF, g, S, E); } }
    GRID_BAR();
    if (PHM & 2) { PHASE_IDS
        constexpr int TT = 16;
        float* red = (float*)(lds + RING_OFF);
        float* stats = red + 8 * 2 * TT;
        const int c = 2 * tid;
        const float bd0 = conv_dw_b[c], bd1 = conv_dw_b[c + 1], lg0 = conv_ln_g[c], lg1 = conv_ln_g[c + 1], lb0 = conv_ln_b[c], lb1 = conv_ln_b[c + 1];
        const float* wdw = conv_dw_w + c;
        float cw0[31], cw1[31];
#pragma unroll
        for (int w = 0; w < 31; ++w) { cw0[w] = wdw[w * D]; cw1[w] = wdw[w * D + 1]; }
        unsigned in[TT + 30];
        for (int kt = 0; kt < (M / TT) / 256; ++kt) { const int tile = vcu * ((M / TT) / 256) + kt;
            const int t0 = tile * TT, pos0 = t0 & (SEQ - 1);
            if (kt == 0) {
#pragma unroll
                for (int j = 0; j < 30; ++j) in[j] = (pos0 + j >= 30) ? *(const unsigned*)(BIG0 + (size_t)(t0 - 30 + j) * D + c) : 0u;
            } else {
#pragma unroll
                for (int j = 0; j < 30; ++j) in[j] = in[j + TT];
            }
#pragma unroll
            for (int j = 30; j < TT + 30; ++j) in[j] = *(const unsigned*)(BIG0 + (size_t)(t0 - 30 + j) * D + c);
            float o0[TT], o1[TT];
            {
                f32x2 op[TT];
#pragma unroll
                for (int i = 0; i < TT; ++i) op[i] = (f32x2){bd0, bd1};
#pragma unroll
                for (int w = 0; w < 31; ++w) { const f32x2 cw = {cw0[w], cw1[w]};
#pragma unroll
                    for (int i = 0; i < TT; ++i) { const f32x2 xv = {bf_lo(in[i + w]), bf_hi(in[i + w])}; op[i] = __builtin_elementwise_fma(xv, cw, op[i]); } }
#pragma unroll
                for (int i = 0; i < TT; ++i) { o0[i] = op[i].x; o1[i] = op[i].y; }
            }
            { float rv[2 * TT];
#pragma unroll
              for (int i = 0; i < TT; ++i) { rv[2 * i] = o0[i] + o1[i]; rv[2 * i + 1] = o0[i] * o0[i] + o1[i] * o1[i]; }
              const int hi5 = lane >> 5;
              float r16[TT];
#pragma unroll
              for (int k = 0; k < TT; ++k) { auto rr = __builtin_amdgcn_permlane32_swap(__float_as_uint(rv[k]), __float_as_uint(rv[k + TT]), false, false);
                  float v = __uint_as_float(rr[0]) + __uint_as_float(rr[1]);
                  v += dpp_f<0x128>(v); v += dpp_f<0x124>(v); v += dpp_f<0x122>(v); v += dpp_f<0x121>(v);
                  r16[k] = v; }
#pragma unroll
              for (int k = 0; k < TT; ++k) r16[k] += __uint_as_float((unsigned)__builtin_amdgcn_ds_swizzle((int)__float_as_uint(r16[k]), 0x401F));
              float mine = r16[0];
#pragma unroll
              for (int k = 1; k < TT; ++k) mine = ((lane & 15) == k) ? r16[k] : mine;
              if ((lane & 16) == 0) red[wave * 2 * TT + (lane & 15) + 16 * hi5] = mine; }
            __syncthreads();
            if (tid < 2 * TT) { float a = 0.f;
#pragma unroll
                for (int w = 0; w < 8; ++w) a += red[w * 2 * TT + tid];
                stats[tid] = a; }
            __syncthreads();
#pragma unroll
            for (int i = 0; i < TT; ++i) { const float mean = stats[2 * i] * (1.f / D); const float var = fmaxf(stats[2 * i + 1] * (1.f / D) - mean * mean, 0.f);
                const float rstd = 1.f / sqrtf(var + LN_EPS);
                float y0 = (o0[i] - mean) * rstd * lg0 + lb0, y1 = (o1[i] - mean) * rstd * lg1 + lb1;
                y0 = y0 / (1.f + __expf(-y0)); y1 = y1 / (1.f + __expf(-y1));
                o0[i] = y0; o1[i] = y1;
                const float wm = wave_max_nl(fmaxf(fabsf(y0), fabsf(y1)));
                if (lane == 0) red[wave * TT + i] = wm; }
            __syncthreads();
            if (tid < TT) { float a = 0.f;
#pragma unroll
                for (int w = 0; w < 8; ++w) a = fmaxf(a, red[w * TT + tid]);
                const float sc = (a > 0.f) ? a * (1.f / 127.f) : 1.f;
                stats[tid] = sc; HSC[t0 + tid] = sc; }
            __syncthreads();
#pragma unroll
            for (int i = 0; i < TT; ++i) { const float inv = 1.f / stats[i];
                int q0 = __float2int_rn(o0[i] * inv), q1 = __float2int_rn(o1[i] * inv); q0 = max(-127, min(127, q0)); q1 = max(-127, min(127, q1));
                *(unsigned short*)((unsigned char*)BIG1 + (size_t)(t0 + i) * D + c) = (unsigned short)(((unsigned)q0 & 255u) | (((unsigned)q1 & 255u) << 8)); }
            __syncthreads();
        }
    }
    GRID_BAR();
    { pg8::Gemm g{(const bf16*)BIG1, (const bf16*)WCO8, M, D, D / 2}; pg8::StaticOrder S; S.init(M, D, G, bx);
      pg8::EpiBf16I8 E{BIG2, D, conv_out_b, 0, 0, 1.f, HSC, WSC + 2048 + NAI_PAD + 4096};
      for (int rep_ = 0; rep_ < NREP_GEMM; ++rep_) {
      pg8::gemm_phase<pg8::EpiBf16I8, pg8::StaticOrder, PG8_ALIGN, PG8_SP2, true>(ldsl + RING_OFF, g, S, E); } }
    GRID_BAR();

    for (int layer = 0; layer < 2; ++layer) {
        if (layer == 1) {
            { pg8::Gemm g{(const bf16*)HB8, (const bf16*)WAI8, M, NAI_PAD, D / 2}; pg8::StaticOrder S; S.init(M, NAI_PAD, G, bx);
              pg8::EpiQkvfI8 E{pg8::EpiBf16I8{BIG0, D, attn_in_b, D, (size_t)(64 * MiB) / 2, attn_body::C2, HSC, WSC + 2048}, LOGF, attn_in_b};
              for (int rep_ = 0; rep_ < NREP_GEMM; ++rep_) {
              pg8::gemm_phase<pg8::EpiQkvfI8, pg8::StaticOrder, PG8_ALIGN, PG8_SP2, true>(ldsl + RING_OFF, g, S, E); } }
            GRID_BAR();
            if (PHM & 4) { PHASE_IDS
                float* kb = (float*)(lds + KB_OFF); float* wsum = (float*)(lds + KB_OFF + 16384);
                const int bh = vcu >> 1;
                const float* lf = LOGF + (size_t)bh * SEQ + 8 * tid;
                const f32x4 a = *(const f32x4*)lf, b = *(const f32x4*)(lf + 4);
                float p[8]; p[0] = a[0]; p[1] = p[0] + a[1]; p[2] = p[1] + a[2]; p[3] = p[2] + a[3]; p[4] = p[3] + b[0]; p[5] = p[4] + b[1]; p[6] = p[5] + b[2]; p[7] = p[6] + b[3];
                float incl = p[7];
#pragma unroll
                for (int o = 1; o < 64; o <<= 1) { const float t = __uint_as_float((unsigned)__builtin_amdgcn_ds_bpermute((lane - o) << 2, (int)__float_as_uint(incl))); if (lane >= o) incl += t; }
                if (lane == 63) wsum[wave] = incl;
                __syncthreads();
                float base = incl - p[7];
                for (int w = 0; w < wave; ++w) base += wsum[w];
#pragma unroll
                for (int i = 0; i < 8; ++i) kb[8 * tid + i] = -(base + p[i]) * 1.4426950408889634f;
                __syncthreads();
                const attn_body::AttnTensors AT{(const attn_body::bf16*)BIG0, (const attn_body::bf16*)BIG1, (const attn_body::bf16*)BIG2, (attn_body::bf16*)HB};
                const attn_body::StaticOrder S(G, bx);
                for (int rep_ = 0; rep_ < NREP_ATTN; ++rep_) attn_body::attn_phase<attn_body::StaticOrder, 100>((char*)lds + RING_OFF, AT, S, (attn_body::lds_fptr)(ldsl + KB_OFF));
            }
            GRID_BAR();
            { pg8::Gemm g{HB, WAO, M, D, D}; pg8::StaticOrder S; S.init(M, D, G, bx);
              pg8::EpiBf16<0> E{BIG1, D, attn_out_b, 0, 0, 1.f};
              for (int rep_ = 0; rep_ < NREP_GEMM; ++rep_) {
      pg8::gemm_phase<pg8::EpiBf16<0>, pg8::StaticOrder, PG8_ALIGN, PG8_SP2>(ldsl + RING_OFF, g, S, E); } }
            GRID_BAR();
        }
        { PHASE_IDS
            const bf16* Y = (layer == 0) ? BIG2 : BIG1; const float* xin = (layer == 0) ? x_in : X;
            const int smix = 2 * layer, sffn = 2 * layer + 1;
            const int b = (gw * 16) >> 12;
            float xn[16]; load16f(xin + (size_t)(gw * 16) * D, lane, xn);
            v4u y0n = *(const v4u*)(Y + (size_t)(gw * 16) * D + 8 * lane), y1n = *(const v4u*)(Y + (size_t)(gw * 16) * D + 512 + 8 * lane);
            for (int r = 0; r < 16; ++r) { const int m = gw * 16 + r;
                float x[16]; const v4u y0 = y0n, y1 = y1n;
#pragma unroll
                for (int i = 0; i < 16; ++i) x[i] = xn[i];
                if (r < 15) { load16f(xin + (size_t)(m + 1) * D, lane, xn); y0n = *(const v4u*)(Y + (size_t)(m + 1) * D + 8 * lane); y1n = *(const v4u*)(Y + (size_t)(m + 1) * D + 512 + 8 * lane); }
                float y[16];
                y[0] = bf_lo(y0.x); y[1] = bf_hi(y0.x); y[2] = bf_lo(y0.y); y[3] = bf_hi(y0.y); y[4] = bf_lo(y0.z); y[5] = bf_hi(y0.z); y[6] = bf_lo(y0.w); y[7] = bf_hi(y0.w);
                y[8] = bf_lo(y1.x); y[9] = bf_hi(y1.x); y[10] = bf_lo(y1.y); y[11] = bf_hi(y1.y); y[12] = bf_lo(y1.z); y[13] = bf_hi(y1.z); y[14] = bf_lo(y1.w); y[15] = bf_hi(y1.w);
                resid_ln_row_pre(x, y, MOD + (size_t)(smix * 8 + b) * 3072 + 2048, ln_mix_g + layer * D, ln_mix_b + layer * D,
                                 X + (size_t)m * D, HB + (size_t)m * D, MOD + (size_t)(sffn * 8 + b) * 3072, lane, HB8 + (size_t)m * D, HSC + m, false); }
        }
        GRID_BAR();
        { pg8::Gemm g{(const bf16*)HB8, (const bf16*)(WPQ8 + (size_t)layer * 2048 * 1024), M, 2048, D / 2}; pg8::StaticOrder S; S.init(M, 2048, G, bx);
          pg8::EpiPqI8 E{BIG0, HSC, WSC + 2048 + NAI_PAD + layer * 2048};
          for (int rep_ = 0; rep_ < NREP_GEMM; ++rep_) {
          pg8::gemm_phase<pg8::EpiPqI8, pg8::StaticOrder, PG8_ALIGN, PG8_SP2, true>(ldsl + RING_OFF, g, S, E); } }
        GRID_BAR();
        if (PHM & 8) { PHASE_IDS
            LAS bf16x8* skf = (LAS bf16x8*)(ldsl + RING_OFF);
            { const bf16* SK = SKB + (size_t)layer * 2 * 16384;
              for (int f = tid; f < 4096; f += NTHR) { const int ln = f & 63, ks = (f >> 6) & 7, kb = (f >> 9) & 3, hf = f >> 11;
                  skf[f] = *(const bf16x8*)(SK + hf * 16384 + (kb * 32 + (ln & 31)) * 128 + ks * 16 + (ln >> 5) * 8); } }
            __syncthreads();
            for (int rep_ = 0; rep_ < NREP_TOPK; ++rep_) for (int it = gw; it < (M / 32) * 8; it += NGW) peer_topk_item(BIG0, skf, IDX, GATE, it >> 3, it & 7, lane); }
        GRID_BAR();
        if (PHM & 16) {
            const int xs = bx & 7, jb = bx >> 3;
            { PHASE_IDS
              for (int rep_ = 0; rep_ < NREP_PU; ++rep_)
              peer_pass_u(xs, jb * 1024 + wave * 128, 128, HB8, IDX, EXP8 + (size_t)(2 * layer) * NEXP * D, (float*)BIG0, lane); }
            GRID_BAR();
            { PHASE_IDS
              peer_pass_a(gw * 16, 16, IDX, GATE, SCL + (size_t)(2 * layer) * NEXP, SCL + (size_t)(2 * layer + 1) * NEXP, (const float*)BIG0, HSC, lane); }
            GRID_BAR();
            { PHASE_IDS
              for (int rep_ = 0; rep_ < NREP_PV; ++rep_)
              peer_pass_v(xs, jb * 1024 + wave * 128, 128, IDX, GATE, EXP8 + (size_t)(2 * layer + 1) * NEXP * D, BIG2, lane); }
            GRID_BAR();
            { PHASE_IDS
              const int sffn = 2 * layer + 1; const int b = (gw * 16) >> 12; const bf16* Y = BIG2;
              float xn[16]; load16f(X + (size_t)(gw * 16) * D, lane, xn);
              v4u y0n = *(const v4u*)(Y + (size_t)(gw * 16) * D + 8 * lane), y1n = *(const v4u*)(Y + (size_t)(gw * 16) * D + 512 + 8 * lane);
              for (int r = 0; r < 16; ++r) { const int m = gw * 16 + r;
                float x[16]; const v4u y0 = y0n, y1 = y1n;
#pragma unroll
                for (int i = 0; i < 16; ++i) x[i] = xn[i];
                if (r < 15) { load16f(X + (size_t)(m + 1) * D, lane, xn); y0n = *(const v4u*)(Y + (size_t)(m + 1) * D + 8 * lane); y1n = *(const v4u*)(Y + (size_t)(m + 1) * D + 512 + 8 * lane); }
                float y[16];
                y[0] = bf_lo(y0.x); y[1] = bf_hi(y0.x); y[2] = bf_lo(y0.y); y[3] = bf_hi(y0.y); y[4] = bf_lo(y0.z); y[5] = bf_hi(y0.z); y[6] = bf_lo(y0.w); y[7] = bf_hi(y0.w);
                y[8] = bf_lo(y1.x); y[9] = bf_hi(y1.x); y[10] = bf_lo(y1.y); y[11] = bf_hi(y1.y); y[12] = bf_lo(y1.z); y[13] = bf_hi(y1.z); y[14] = bf_lo(y1.w); y[15] = bf_hi(y1.w);
                resid_ln_row_pre(x, y, MOD + (size_t)(sffn * 8 + b) * 3072 + 2048, ln_ffn_g + layer * D, ln_ffn_b + layer * D,
                                 X + (size_t)m * D, HB + (size_t)m * D, (layer == 0) ? MOD + (size_t)(2 * 8 + b) * 3072 : nullptr, lane, HB8 + (size_t)m * D, HSC + m, false); } }
        }
        if (layer == 0) GRID_BAR();
    }
}

extern "C" void kernel_launch(void* const* d_in, const int* in_sizes, int n_in, void* d_out, int out_size, void* d_ws, size_t ws_size, hipStream_t stream) {
    static int grid = 0;
    if (grid == 0) {
        if (n_in != 27 || in_sizes[0] != M * D || out_size != M * D || ws_size < WS_END) { fprintf(stderr, "kernel_launch: unexpected shapes (n_in %d, in0 %d, out %d, ws %zu); nothing launched\n", n_in, n_in > 0 ? in_sizes[0] : -1, out_size, ws_size); grid = -1; return; }
        int dev = 0, cus = 0, per_cu = 0;
        if (hipGetDevice(&dev) != hipSuccess || hipDeviceGetAttribute(&cus, hipDeviceAttributeMultiprocessorCount, dev) != hipSuccess) { grid = -1; return; }
        if (hipFuncSetAttribute((const void*)trunk_fwd, hipFuncAttributeMaxDynamicSharedMemorySize, LDS_BYTES) != hipSuccess) { fprintf(stderr, "kernel_launch: hipFuncSetAttribute failed\n"); grid = -1; return; }
        if (hipOccupancyMaxActiveBlocksPerMultiprocessor(&per_cu, (const void*)trunk_fwd, NTHR, LDS_BYTES) != hipSuccess || per_cu < 1) { fprintf(stderr, "kernel_launch: occupancy query reports %d blocks per CU\n", per_cu); }
        (void)hipGetLastError();
        grid = cus;
        if (grid != 256) fprintf(stderr, "kernel_launch: %d CUs; this build expects 256\n", grid);
    }
    if (grid < 0) return;
    if (hipMemsetAsync((char*)d_ws + WS_CTL, 0, CTL_ZERO_BYTES, stream) != hipSuccess) return;
    Args a{};
    for (int i = 0; i < 27; ++i) a.in[i] = (const float*)d_in[i];
    a.out = (float*)d_out; a.ws = (unsigned char*)d_ws;
    hipLaunchKernelGGL(trunk_fwd, dim3(grid), dim3(NTHR), LDS_BYTES, stream, a);
}
```
